# Optimizing an MI355X kernel written in HIP

```python
import math
import jax, jax.numpy as jnp
from jax import lax
import numpy as np

D_MODEL = 2048
BATCH = 32
SEQ = 256
DEPTH = 2
DEC_BATCH = 8
DEC_SEQ = 4096
PAST_LEN = 256

GRID_W = 64
HEAD_DIM = 128
NA_HEADS = 8
NA_WIN_R = 8
NA_WIN_C = 16
GDN_HEADS = 8
GDN_CONV = 3
GDN_CHUNK = 64
DIFF_HEADS = 4
D_FF = 5632
N_MOD = 9
Q_BLOCK = 128
ROPE_BASE = 10000.0
EPS = 1e-6
NA_W = NA_HEADS * HEAD_DIM
GDN_W = GDN_HEADS * HEAD_DIM
DIFF_W = DIFF_HEADS * 2 * HEAD_DIM
IN_SPLITS = (NA_W, NA_W, NA_W, GDN_W, GDN_W, GDN_W, GDN_W, 4 * GDN_HEADS, DIFF_W, DIFF_W, DIFF_W, 3 * D_MODEL)
D_IN = sum(IN_SPLITS)

kernel_name = 'hybrid_na_gdn_diff_diffusion_step'


def rmsnorm(x, w):
    xf = x.astype(jnp.float32)
    y = xf * lax.rsqrt(jnp.mean(xf * xf, axis=-1, keepdims=True) + EPS)
    return (y * w.astype(jnp.float32)).astype(x.dtype)


def l2norm(x):
    xf = x.astype(jnp.float32)
    return xf * lax.rsqrt(jnp.sum(xf * xf, axis=-1, keepdims=True) + EPS)


def swiglu(h, w_gu, w_dn):
    g, u = jnp.split(h @ w_gu, 2, axis=-1)
    return (jax.nn.silu(g) * u) @ w_dn


def modulation(cvec, w_mod, b_mod):
    m = jax.nn.silu(cvec) @ w_mod + b_mod
    return m.reshape(cvec.shape[0], N_MOD, D_MODEL)


def modulated_norm(x, mod, i, w_pre):
    shift = mod[:, 3 * i][:, None]
    scale = mod[:, 3 * i + 1][:, None]
    return rmsnorm(x, w_pre) * (1 + scale) + shift


def gated_residual(x, y, mod, i, w_post, coef):
    return x + coef * mod[:, 3 * i + 2][:, None] * rmsnorm(y, w_post)


def axial_rope_tables(n_tok):
    t = jnp.arange(n_tok)
    pos = jnp.stack([t // GRID_W, t % GRID_W], axis=-1).astype(jnp.float32)
    nq = HEAD_DIM // 4
    inv = ROPE_BASE ** (-jnp.arange(nq, dtype=jnp.float32) / nq)
    ang = pos[:, :, None] * inv
    return jnp.cos(ang)[:, :, None, :], jnp.sin(ang)[:, :, None, :]


def apply_axial_rope(x, cos, sin):
    shp = x.shape
    n_mid = len(shp) - 3
    xr = x.astype(jnp.float32).reshape(shp[:-1] + (2, 2, HEAD_DIM // 4))
    c = cos.reshape((cos.shape[0],) + (1,) * n_mid + cos.shape[1:])
    s = sin.reshape((sin.shape[0],) + (1,) * n_mid + sin.shape[1:])
    rot = jnp.stack([-xr[..., 1, :], xr[..., 0, :]], axis=-2)
    return (xr * c + rot * s).reshape(shp).astype(x.dtype)


def softmax_attend(q, k, v):
    s = jnp.einsum('bqhd,bkhd->bhqk', q, k).astype(jnp.float32) * HEAD_DIM ** -0.5
    p = jax.nn.softmax(s, axis=-1).astype(v.dtype)
    return jnp.einsum('bhqk,bkhd->bqhd', p, v)


def na_latent(q, k, v, kc, vc, rpb):
    B, T, H, d = q.shape
    rows = T // GRID_W
    wr = min(NA_WIN_R, rows)
    qg = (q * HEAD_DIM ** -0.5).reshape(B, rows, GRID_W, H, d)
    kg = k.reshape(B, rows, GRID_W, H, d)
    vg = v.reshape(B, rows, GRID_W, H, d)
    col = jnp.arange(GRID_W)
    col_start = jnp.clip(col - NA_WIN_C // 2, 0, GRID_W - NA_WIN_C)
    col_idx = col_start[:, None] + jnp.arange(NA_WIN_C)
    dc = col_idx - col[:, None] + NA_WIN_C - 1
    n_loc = wr * NA_WIN_C

    def one_row(r):
        rs = jnp.clip(r - NA_WIN_R // 2, 0, rows - wr)
        qr = lax.dynamic_index_in_dim(qg, r, axis=1, keepdims=False)
        kr = lax.dynamic_slice_in_dim(kg, rs, wr, axis=1)
        vr = lax.dynamic_slice_in_dim(vg, rs, wr, axis=1)
        kw = kr[:, :, col_idx]
        vw = vr[:, :, col_idx]
        dr = rs + jnp.arange(wr) - r + NA_WIN_R - 1
        bias = rpb[:, dr[None, :, None], dc[:, None, :]]
        s_loc = jnp.einsum('bqhd,brqchd->bhqrc', qr, kw).astype(jnp.float32) + bias.astype(jnp.float32)[None]
        s_ctx = jnp.einsum('bqhd,bkhd->bhqk', qr, kc).astype(jnp.float32)
        s = jnp.concatenate([s_loc.reshape(B, H, GRID_W, n_loc), s_ctx], axis=-1)
        p = jax.nn.softmax(s, axis=-1).astype(v.dtype)
        p_loc = p[..., :n_loc].reshape(B, H, GRID_W, wr, NA_WIN_C)
        p_ctx = p[..., n_loc:]
        return jnp.einsum('bhqrc,brqchd->bqhd', p_loc, vw) + jnp.einsum('bhqk,bkhd->bqhd', p_ctx, vc)

    o = lax.map(one_row, jnp.arange(rows))
    return jnp.moveaxis(o, 0, 1).reshape(B, T, H, d)


def short_conv(x, w):
    K = w.shape[0]
    pad = K // 2
    T = x.shape[1]
    xp = jnp.pad(x, ((0, 0), (pad, pad), (0, 0)))
    out = xp[:, 0:T] * w[0]
    for j in range(1, K):
        out = out + xp[:, j:j + T] * w[j]
    return out


def gdn_inputs(g_q, g_k, g_v, g_ab, conv_w, a_log, dt_bias):
    B, T, _ = g_q.shape
    qkv = jax.nn.silu(short_conv(jnp.concatenate([g_q, g_k, g_v], axis=-1), conv_w))
    q, k, v = jnp.split(qkv, 3, axis=-1)
    q = l2norm(q.reshape(B, T, GDN_HEADS, HEAD_DIM)) * HEAD_DIM ** -0.5
    k = l2norm(k.reshape(B, T, GDN_HEADS, HEAD_DIM))
    v = v.reshape(B, T, GDN_HEADS, HEAD_DIM).astype(jnp.float32)
    ab = g_ab.astype(jnp.float32).reshape(B, T, 4, GDN_HEADS)
    beta = jax.nn.sigmoid(ab[:, :, 0:2])
    log_a = -jnp.exp(a_log.astype(jnp.float32)) * jax.nn.softplus(ab[:, :, 2:4] + dt_bias.astype(jnp.float32))
    return q, k, v, beta, log_a


def chunked_gated_delta(q, k, v, beta, log_a, s0):
    B, T, H, dk = q.shape
    dv = v.shape[-1]
    C = GDN_CHUNK
    n = T // C

    def chunks(t):
        t = t.reshape((B, n, C, H) + t.shape[3:])
        return jnp.moveaxis(jnp.moveaxis(t, 1, 0), 3, 2)

    qc, kc, vc = chunks(q), chunks(k), chunks(v)
    bc, gc = chunks(beta), chunks(log_a)
    gam = jnp.cumsum(gc, axis=-1)
    diff = gam[..., :, None] - gam[..., None, :]
    strict = jnp.tril(jnp.ones((C, C), bool), -1)
    incl = jnp.tril(jnp.ones((C, C), bool))
    dec_strict = jnp.exp(jnp.where(strict, diff, -jnp.inf))
    dec_incl = jnp.exp(jnp.where(incl, diff, -jnp.inf))
    kk = jnp.einsum('nbhid,nbhjd->nbhij', kc, kc)
    a_mat = jnp.eye(C, dtype=jnp.float32) + bc[..., :, None] * kk * dec_strict
    rhs = jnp.concatenate([bc[..., None] * vc, (bc * jnp.exp(gam))[..., None] * kc], axis=-1)
    sol = lax.linalg.triangular_solve(a_mat, rhs, left_side=True, lower=True, unit_diagonal=True)
    u, wk = sol[..., :dv], sol[..., dv:]
    p = jnp.einsum('nbhid,nbhjd->nbhij', qc, kc) * dec_incl
    qg = qc * jnp.exp(gam)[..., None]
    kd = kc * jnp.exp(gam[..., -1:] - gam)[..., None]
    g_last = jnp.exp(gam[..., -1])

    def step(s, xs):
        u_i, wk_i, p_i, qg_i, kd_i, gl_i = xs
        w_i = u_i - jnp.einsum('bhck,bhkv->bhcv', wk_i, s)
        o_i = jnp.einsum('bhck,bhkv->bhcv', qg_i, s) + jnp.einsum('bhij,bhjv->bhiv', p_i, w_i)
        s = gl_i[..., None, None] * s + jnp.einsum('bhck,bhcv->bhkv', kd_i, w_i)
        return s, o_i

    s_fin, o = lax.scan(step, s0, (u, wk, p, qg, kd, g_last))
    o = jnp.moveaxis(jnp.moveaxis(o, 2, 3), 0, 1).reshape(B, T, H, dv)
    return o, s_fin


def reverse_tokens(t):
    return t[:, ::-1]


def gdn_bidir(q, k, v, beta, log_a, s0_f, s0_b):
    o_f, s_f = chunked_gated_delta(q, k, v, beta[:, :, 0], log_a[:, :, 0], s0_f)
    o_b, s_b = chunked_gated_delta(reverse_tokens(q), reverse_tokens(k), reverse_tokens(v),
                                   reverse_tokens(beta[:, :, 1]), reverse_tokens(log_a[:, :, 1]), s0_b)
    return o_f + reverse_tokens(o_b), s_f, s_b


def diff_lambda_value(lam, l):
    lam_init = 0.8 - 0.6 * math.exp(-0.3 * l)
    lf = lam.astype(jnp.float32)
    val = jnp.exp(jnp.sum(lf[0] * lf[1])) - jnp.exp(jnp.sum(lf[2] * lf[3])) + lam_init
    return val, lam_init


def diff_combine(s, v, lam):
    p = jax.nn.softmax(s, axis=-1)
    a = p[:, :, 0] - lam * p[:, :, 1]
    return jnp.einsum('bhqk,bkhe->bqhe', a.astype(v.dtype), v)


def diff_latent(q, k, v, kc, vc, lam):
    B, T = q.shape[:2]
    keys = jnp.concatenate([k, kc.astype(k.dtype)], axis=1)
    vals = jnp.concatenate([v, vc.astype(v.dtype)], axis=1)
    nb = T // Q_BLOCK
    qb = jnp.moveaxis(q.reshape(B, nb, Q_BLOCK, DIFF_HEADS, 2, HEAD_DIM), 1, 0)

    def one_block(qi):
        s = jnp.einsum('bqhmd,bkhmd->bhmqk', qi, keys).astype(jnp.float32) * HEAD_DIM ** -0.5
        return diff_combine(s, vals, lam)

    o = lax.map(one_block, qb)
    return jnp.moveaxis(o, 0, 1).reshape(B, T, DIFF_HEADS, 2 * HEAD_DIM)


def run_layer(x, mod, l, lw, cache=None):
    B, T, _ = x.shape
    h = modulated_norm(x, mod, 0, lw['norm_pre'][0])
    x = gated_residual(x, swiglu(h, lw['ffn1_w_gu'], lw['ffn1_w_dn']), mod, 0, lw['norm_post'][0], 0.5)

    h = modulated_norm(x, mod, 1, lw['norm_pre'][1])
    offs = np.cumsum(IN_SPLITS)[:-1].tolist()
    (na_q, na_k, na_v, g_q, g_k, g_v, g_z, g_ab, d_q, d_k, d_v, gates) = jnp.split(h @ lw['w_in'], offs, axis=-1)
    na_q = na_q.reshape(B, T, NA_HEADS, HEAD_DIM)
    na_k = na_k.reshape(B, T, NA_HEADS, HEAD_DIM)
    na_v = na_v.reshape(B, T, NA_HEADS, HEAD_DIM)
    d_q = d_q.reshape(B, T, DIFF_HEADS, 2, HEAD_DIM)
    d_k = d_k.reshape(B, T, DIFF_HEADS, 2, HEAD_DIM)
    d_v = d_v.reshape(B, T, DIFF_HEADS, 2 * HEAD_DIM)
    q_g, k_g, v_g, beta, log_a = gdn_inputs(g_q, g_k, g_v, g_ab, lw['gdn_conv'], lw['gdn_a_log'], lw['gdn_dt_bias'])
    lam, lam_init = diff_lambda_value(lw['diff_lambda'], l)

    if cache is None:
        o_na = softmax_attend(na_q, na_k, na_v)
        s0 = jnp.zeros((B, GDN_HEADS, HEAD_DIM, HEAD_DIM), jnp.float32)
        o_g, s_f, s_b = gdn_bidir(q_g, k_g, v_g, beta, log_a, s0, s0)
        s = jnp.einsum('bqhmd,bkhmd->bhmqk', d_q, d_k).astype(jnp.float32) * HEAD_DIM ** -0.5
        o_d = diff_combine(s, d_v, lam)
        ctx_tensors = (na_k, na_v, jnp.stack([s_f, s_b], axis=1).astype(x.dtype), d_k, d_v)
    else:
        kc_na, vc_na, st, kc_d, vc_d = cache
        o_na = na_latent(na_q, na_k, na_v, kc_na.astype(na_k.dtype), vc_na.astype(na_v.dtype), lw['na_rpb'])
        o_g, _, _ = gdn_bidir(q_g, k_g, v_g, beta, log_a, st[:, 0].astype(jnp.float32), st[:, 1].astype(jnp.float32))
        cos, sin = axial_rope_tables(T)
        o_d = diff_latent(apply_axial_rope(d_q, cos, sin), apply_axial_rope(d_k, cos, sin), d_v, kc_d, vc_d, lam)
        ctx_tensors = None

    o_g = (rmsnorm(o_g, lw['gdn_norm']) * jax.nn.silu(g_z.reshape(B, T, GDN_HEADS, HEAD_DIM).astype(jnp.float32))).astype(x.dtype)
    o_d = rmsnorm(o_d, lw['diff_norm']) * (1.0 - lam_init)
    gate = jax.nn.sigmoid(gates.astype(jnp.float32)).astype(x.dtype).reshape(B, T, 3, D_MODEL)
    merged = (gate[:, :, 0] * (o_na.reshape(B, T, NA_W) @ lw['w_branch_na'])
              + gate[:, :, 1] * (o_g.reshape(B, T, GDN_W) @ lw['w_branch_gdn'])
              + gate[:, :, 2] * (o_d.reshape(B, T, DIFF_W) @ lw['w_branch_diff']))
    x = gated_residual(x, merged @ lw['w_out'], mod, 1, lw['norm_post'][1], 1.0)

    h = modulated_norm(x, mod, 2, lw['norm_pre'][2])
    x = gated_residual(x, swiglu(h, lw['ffn2_w_gu'], lw['ffn2_w_dn']), mod, 2, lw['norm_post'][2], 0.5)
    return x, ctx_tensors


def setup_inputs(seed: int = 0) -> dict:
    key = jax.random.key(seed)
    ks = jax.random.split(key, 32)
    f32 = jnp.float32
    L = DEPTH

    def nrm(i, shape, scale):
        return jax.random.normal(ks[i], shape, f32) * scale

    dt = jnp.exp(jax.random.uniform(ks[20], (L, 2, GDN_HEADS), f32, math.log(1e-3), math.log(1e-1)))
    return {
        'x_prompt': nrm(0, (BATCH, SEQ, D_MODEL), 1.0),
        'x_sample': nrm(1, (DEC_BATCH, DEC_SEQ, D_MODEL), 1.0),
        'cache_na_k': nrm(2, (DEC_BATCH, L, PAST_LEN, NA_HEADS, HEAD_DIM), 1.0),
        'cache_na_v': nrm(3, (DEC_BATCH, L, PAST_LEN, NA_HEADS, HEAD_DIM), 1.0),
        'state_gdn': nrm(4, (DEC_BATCH, L, 2, GDN_HEADS, HEAD_DIM, HEAD_DIM), 0.1),
        'cache_diff_k': nrm(5, (DEC_BATCH, L, PAST_LEN, DIFF_HEADS, 2, HEAD_DIM), 1.0),
        'cache_diff_v': nrm(6, (DEC_BATCH, L, PAST_LEN, DIFF_HEADS, 2 * HEAD_DIM), 1.0),
        'c': nrm(7, (DEC_BATCH, D_MODEL), 1.0),
        'c_ctx': nrm(8, (D_MODEL,), 1.0),
        'w_mod': nrm(9, (L, D_MODEL, N_MOD * D_MODEL), 0.5 * D_MODEL ** -0.5),
        'b_mod': nrm(10, (L, N_MOD * D_MODEL), 0.01),
        'norm_pre': 1.0 + nrm(11, (L, 3, D_MODEL), 0.02),
        'norm_post': 1.0 + nrm(12, (L, 3, D_MODEL), 0.02),
        'ffn1_w_gu': nrm(13, (L, D_MODEL, 2 * D_FF), D_MODEL ** -0.5),
        'ffn1_w_dn': nrm(14, (L, D_FF, D_MODEL), D_FF ** -0.5),
        'ffn2_w_gu': nrm(15, (L, D_MODEL, 2 * D_FF), D_MODEL ** -0.5),
        'ffn2_w_dn': nrm(16, (L, D_FF, D_MODEL), D_FF ** -0.5),
        'w_in': nrm(17, (L, D_MODEL, D_IN), D_MODEL ** -0.5),
        'na_rpb': nrm(18, (L, NA_HEADS, 2 * NA_WIN_R - 1, 2 * NA_WIN_C - 1), 0.1),
        'gdn_conv': nrm(19, (L, GDN_CONV, 3 * GDN_W), GDN_CONV ** -0.5),
        'gdn_a_log': jnp.log(jax.random.uniform(ks[21], (L, 2, GDN_HEADS), f32, 1.0, 16.0)),
        'gdn_dt_bias': dt + jnp.log(-jnp.expm1(-dt)),
        'gdn_norm': 1.0 + nrm(22, (L, HEAD_DIM), 0.02),
        'diff_lambda': nrm(23, (L, 4, HEAD_DIM), 0.1),
        'diff_norm': 1.0 + nrm(24, (L, 2 * HEAD_DIM), 0.02),
        'w_branch_na': nrm(25, (L, NA_W, D_MODEL), NA_W ** -0.5),
        'w_branch_gdn': nrm(26, (L, GDN_W, D_MODEL), GDN_W ** -0.5),
        'w_branch_diff': nrm(27, (L, DIFF_W, D_MODEL), DIFF_W ** -0.5),
        'w_out': nrm(28, (L, D_MODEL, D_MODEL), D_MODEL ** -0.5),
    }


def reference(x_prompt, x_sample, cache_na_k, cache_na_v, state_gdn, cache_diff_k, cache_diff_v, c, c_ctx,
              w_mod, b_mod, norm_pre, norm_post, ffn1_w_gu, ffn1_w_dn, ffn2_w_gu, ffn2_w_dn, w_in, na_rpb,
              gdn_conv, gdn_a_log, gdn_dt_bias, gdn_norm, diff_lambda, diff_norm, w_branch_na, w_branch_gdn,
              w_branch_diff, w_out):
    y_prompt = x_prompt
    y_sample = x_sample
    na_k_l, na_v_l, gdn_s_l, diff_k_l, diff_v_l = [], [], [], [], []
    for l in range(DEPTH):
        lw = {
            'norm_pre': norm_pre[l], 'norm_post': norm_post[l],
            'ffn1_w_gu': ffn1_w_gu[l], 'ffn1_w_dn': ffn1_w_dn[l],
            'ffn2_w_gu': ffn2_w_gu[l], 'ffn2_w_dn': ffn2_w_dn[l],
            'w_in': w_in[l], 'na_rpb': na_rpb[l], 'gdn_conv': gdn_conv[l],
            'gdn_a_log': gdn_a_log[l], 'gdn_dt_bias': gdn_dt_bias[l], 'gdn_norm': gdn_norm[l],
            'diff_lambda': diff_lambda[l], 'diff_norm': diff_norm[l],
            'w_branch_na': w_branch_na[l], 'w_branch_gdn': w_branch_gdn[l],
            'w_branch_diff': w_branch_diff[l], 'w_out': w_out[l],
        }
        mod_ctx = modulation(c_ctx[None], w_mod[l], b_mod[l])
        mod_lat = modulation(c, w_mod[l], b_mod[l])
        y_prompt, (k_na, v_na, s_gdn, k_d, v_d) = run_layer(y_prompt, mod_ctx, l, lw)
        na_k_l.append(k_na)
        na_v_l.append(v_na)
        gdn_s_l.append(s_gdn)
        diff_k_l.append(k_d)
        diff_v_l.append(v_d)
        layer_cache = (cache_na_k[:, l], cache_na_v[:, l], state_gdn[:, l], cache_diff_k[:, l], cache_diff_v[:, l])
        y_sample, _ = run_layer(y_sample, mod_lat, l, lw, layer_cache)
    new_na_k = jnp.stack(na_k_l, axis=1)
    new_na_v = jnp.stack(na_v_l, axis=1)
    new_gdn_state = jnp.stack(gdn_s_l, axis=1)
    new_diff_k = jnp.stack(diff_k_l, axis=1)
    new_diff_v = jnp.stack(diff_v_l, axis=1)
    return (y_prompt, y_sample, new_na_k, new_na_v, new_gdn_state, new_diff_k, new_diff_v)
```

```cpp
#include <hip/hip_runtime.h>
#include <cstdio>
#include <cstdint>
#ifndef MK_ONE_LAUNCH
#define MK_ONE_LAUNCH 1
#endif
#define AT2_SDEPTH 1
namespace pg8 {
#define PG8_LAS __attribute__((address_space(3)))
typedef unsigned short bf16_t;
typedef short bf16x8 __attribute__((ext_vector_type(8)));
typedef float f32x4 __attribute__((ext_vector_type(4)));
typedef unsigned u32x4 __attribute__((ext_vector_type(4)));
constexpr int BM = 256, BK = 64, HALF = 128, HTB = HALF * BK * 2  , STAGE_BYTES = 8 * HTB, NXCD = 8, WGM = 8;

__host__ __device__ __forceinline__ int lds_byte(int r, int c) { const int st = (r >> 4) * 2 + (c >> 5), rr = r & 15, cc = c & 31, ob = rr * 64 + cc * 2; return st * 1024 + (ob ^ (((ob >> 9) & 1) << 5)); }
__host__ __device__ __forceinline__ void stage_rc(int b, int& R, int& C) { const int st = b / 1024, sb = b % 1024, swz = sb ^ (((sb >> 9) & 1) << 5); R = (st >> 1) * 16 + swz / 64; C = (st & 1) * 32 + (swz % 64) / 2; }
__host__ __device__ __forceinline__ int perm32(int rho) { const int n = rho >> 4, i = rho & 15; return 8 * (i >> 2) + 4 * n + (i & 3); }

struct Unit { int pm, pn; };
struct Gemm { const bf16_t* A; const bf16_t* Bt; int M, N, K; };

struct StaticOrder {
    int nM, nN, nwg, G, c;
    __host__ __device__ void init(int M, int N, int G_, int c_) { nM = M / BM; nN = N / BM; nwg = nM * nN; G = G_; c = c_; }
    __host__ __device__ bool next(int i, Unit& u) const {
        const long L = (long)i * G + c; if (L >= nwg) return false;
        int wgid = (int)L; { const int q = nwg / NXCD, r = nwg % NXCD, xcd = wgid % NXCD, off = wgid / NXCD; wgid = (xcd < r ? xcd * (q + 1) : r * (q + 1) + (xcd - r) * q) + off; }
        const int nig = WGM * nN, gid = wgid / nig, fm = gid * WGM, gsz = (nM - fm) < WGM ? (nM - fm) : WGM;
        u.pm = fm + ((wgid % nig) % gsz); u.pn = (wgid % nig) / gsz; return true;
    }
    __device__ __forceinline__ void a_ready(const Unit&) const {}
    __device__ __forceinline__ void done(const Unit&) const {}
};
__device__ __forceinline__ unsigned cvt_pk_bf16(float lo, float hi) { unsigned r; asm volatile("v_cvt_pk_bf16_f32 %0, %1, %2" : "=v"(r) : "v"(lo), "v"(hi)); return r; }
template <class Epi, class Sched, bool ALIGN_EPI = false, bool SP2 = false>
__device__ __forceinline__ void gemm_phase(PG8_LAS unsigned char* lds, const Gemm g, const Sched& S, const Epi& E) {
    int tid_l = threadIdx.x; asm volatile("" : "+v"(tid_l));
    const int tid = tid_l, wid = __builtin_amdgcn_readfirstlane(tid >> 6), lane = tid & 63, wr = wid >> 2, wc = wid & 3, fr = lane & 15, fq = lane >> 4;
    const int K = g.K, nt = K / BK;
    unsigned voffA[2], voffB[2];
#pragma unroll
    for (int i = 0; i < 2; ++i) { int R, C; stage_rc(tid * 16 + i * 8192, R, C); const int Rb = (int)Epi::PERM == 2 ? (64 * (R >> 5) + perm32(R & 31)) : (Epi::PERM ? ((R & ~31) + perm32(R & 31)) : R);
        voffA[i] = (unsigned)(R * K + C) * 2u; voffB[i] = (unsigned)(Rb * K + C) * 2u; }
    const size_t kstep = (size_t)(BK * 2);
    const size_t hstep = (size_t)HALF * K * 2;
    const size_t hstepB = (int)Epi::PERM == 2 ? (size_t)32 * K * 2 : hstep;
    const size_t tstep = 2 * hstep;
    const unsigned ldsw = (unsigned)wid * 1024u;
    const int aoff = lds_byte(wr * 64 + fr, fq * 8), boff = lds_byte(wc * 32 + fr, fq * 8);
#define PG8_SA(b, h) (((b) * 2 + (h)) * HTB)
#define PG8_SB(b, h) ((4 + (b) * 2 + (h)) * HTB)
#define PG8_STAGE(bufoff, gbase, voff) do { _Pragma("unroll") for (int _i = 0; _i < 2; ++_i) \
        __builtin_amdgcn_global_load_lds((const unsigned*)((const char*)(gbase) + (voff)[_i]), (PG8_LAS unsigned*)(lds + (bufoff) + ldsw + _i * 8192), 16, 0, 0); } while (0)
#define PG8_LDA(dst, b, h) do { _Pragma("unroll") for (int m = 0; m < 4; ++m) _Pragma("unroll") for (int k = 0; k < 2; ++k) dst[m][k] = *(const PG8_LAS bf16x8*)(lds + PG8_SA(b, h) + aoff + m * 2048 + k * 1024); } while (0)
#define PG8_LDB(dst, b, h) do { _Pragma("unroll") for (int n = 0; n < 2; ++n) _Pragma("unroll") for (int k = 0; k < 2; ++k) dst[n][k] = *(const PG8_LAS bf16x8*)(lds + PG8_SB(b, h) + boff + n * 2048 + k * 1024); } while (0)
#define PG8_MMA(ai, bj, At, Bt) do { __builtin_amdgcn_s_setprio(1); _Pragma("unroll") for (int m = 0; m < 4; ++m) _Pragma("unroll") for (int n = 0; n < 2; ++n) _Pragma("unroll") for (int k = 0; k < 2; ++k) \
        acc[ai][bj][m][n] = __builtin_amdgcn_mfma_f32_16x16x32_bf16(Bt[n][k], At[m][k], acc[ai][bj][m][n], 0, 0, 0); __builtin_amdgcn_s_setprio(0); } while (0)
#define PG8_WAIT_V(n) asm volatile("s_waitcnt vmcnt(" #n ")" ::: "memory")
#define PG8_WAIT_L(n) asm volatile("s_waitcnt lgkmcnt(" #n ")" ::: "memory")
#define PG8_BAR __builtin_amdgcn_s_barrier()
#define PG8_SCHED __builtin_amdgcn_sched_barrier(0)
    Unit cur, nxt; int ui = 0;
    if (!S.next(0, cur)) return;
    f32x4 acc[2][2][4][2];
#pragma unroll
    for (int a = 0; a < 2; ++a)
#pragma unroll
        for (int b = 0; b < 2; ++b)
#pragma unroll
            for (int m = 0; m < 4; ++m)
#pragma unroll
                for (int n = 0; n < 2; ++n) acc[a][b][m][n] = (f32x4){0.f, 0.f, 0.f, 0.f};
    bf16x8 At[4][2], B0[2][2], B1[2][2];
    const char* cA = (const char*)g.A + (size_t)cur.pm * tstep; const char* cB = (const char*)g.Bt + (size_t)cur.pn * tstep;
    S.a_ready(cur);
    if constexpr (SP2) {
        PG8_STAGE(PG8_SB(0, 0), cB, voffB); PG8_STAGE(PG8_SB(0, 1), cB + hstepB, voffB); PG8_STAGE(PG8_SA(0, 0), cA, voffA); PG8_STAGE(PG8_SA(0, 1), cA + hstep, voffA);
        if (wr == 1) PG8_BAR;
        PG8_WAIT_V(2); PG8_BAR;
        PG8_STAGE(PG8_SB(1, 0), cB + kstep, voffB); PG8_STAGE(PG8_SA(1, 0), cA + kstep, voffA); PG8_STAGE(PG8_SB(1, 1), cB + hstepB + kstep, voffB);
        PG8_WAIT_V(6); PG8_BAR;
    } else {
        PG8_STAGE(PG8_SB(0, 0), cB, voffB); PG8_STAGE(PG8_SA(0, 0), cA, voffA); PG8_STAGE(PG8_SB(0, 1), cB + hstepB, voffB); PG8_STAGE(PG8_SA(0, 1), cA + hstep, voffA);
        if (wr == 1) PG8_BAR;
        PG8_WAIT_V(4); PG8_BAR;
        PG8_STAGE(PG8_SB(1, 0), cB + kstep, voffB); PG8_STAGE(PG8_SA(1, 0), cA + kstep, voffA); PG8_STAGE(PG8_SB(1, 1), cB + hstepB + kstep, voffB);
        PG8_WAIT_V(6); PG8_BAR;
    }
    for (;;) {
        const bool has_next = S.next(ui + 1, nxt);
        const char* nA = has_next ? (const char*)g.A + (size_t)nxt.pm * tstep : cA; const char* nB = has_next ? (const char*)g.Bt + (size_t)nxt.pn * tstep : cB;
        for (int t = 0; t < nt; t += 2) {
            const bool last = (t == nt - 2);
            const char* a1 = cA + (size_t)(t + 1) * kstep;
            const char* a2 = last ? nA : cA + (size_t)(t + 2) * kstep; const char* b2 = last ? nB : cB + (size_t)(t + 2) * kstep;
            const char* a3 = a2 + kstep; const char* b3 = b2 + kstep;
            if (last && has_next) S.a_ready(nxt);
            if constexpr (SP2) {
            PG8_LDB(B0, 0, 0); PG8_LDB(B1, 0, 1); PG8_SCHED; PG8_LDA(At, 0, 0); PG8_STAGE(PG8_SA(1, 1), a1 + hstep, voffA);
            PG8_WAIT_V(8); PG8_WAIT_L(0); PG8_BAR; PG8_MMA(0, 0, At, B0); PG8_MMA(0, 1, At, B1); PG8_BAR; PG8_SCHED;
            PG8_LDA(At, 0, 1); PG8_STAGE(PG8_SB(0, 0), b2, voffB); PG8_STAGE(PG8_SB(0, 1), b2 + hstepB, voffB); PG8_STAGE(PG8_SA(0, 0), a2, voffA);
            PG8_WAIT_V(8); PG8_WAIT_L(0); PG8_BAR; PG8_MMA(1, 0, At, B0); PG8_MMA(1, 1, At, B1); PG8_BAR; PG8_SCHED;
            PG8_LDB(B0, 1, 0); PG8_LDB(B1, 1, 1); PG8_SCHED; PG8_LDA(At, 1, 0); PG8_STAGE(PG8_SA(0, 1), a2 + hstep, voffA);
            PG8_WAIT_V(8); PG8_WAIT_L(0); PG8_BAR; PG8_MMA(0, 0, At, B0); PG8_MMA(0, 1, At, B1); PG8_BAR; PG8_SCHED;
            PG8_LDA(At, 1, 1); PG8_STAGE(PG8_SB(1, 0), b3, voffB); PG8_STAGE(PG8_SB(1, 1), b3 + hstepB, voffB); PG8_STAGE(PG8_SA(1, 0), a3, voffA);
            PG8_WAIT_V(8); PG8_WAIT_L(0); PG8_BAR; PG8_MMA(1, 0, At, B0); PG8_MMA(1, 1, At, B1); PG8_BAR; PG8_SCHED;
            } else {
            PG8_LDB(B0, 0, 0); PG8_SCHED; PG8_LDA(At, 0, 0); PG8_STAGE(PG8_SA(1, 1), a1 + hstep, voffA);
            PG8_WAIT_L(8); PG8_BAR; PG8_WAIT_L(0); PG8_MMA(0, 0, At, B0); PG8_BAR; PG8_SCHED;
            PG8_LDB(B1, 0, 1); PG8_STAGE(PG8_SB(0, 0), b2, voffB);
            PG8_BAR; PG8_WAIT_L(0); PG8_MMA(0, 1, At, B1); PG8_BAR;
            PG8_LDA(At, 0, 1); PG8_STAGE(PG8_SA(0, 0), a2, voffA);
            PG8_BAR; PG8_WAIT_L(0); PG8_MMA(1, 0, At, B0); PG8_BAR; PG8_SCHED;
            PG8_STAGE(PG8_SB(0, 1), b2 + hstepB, voffB);
            PG8_WAIT_V(6); PG8_BAR; PG8_MMA(1, 1, At, B1); PG8_BAR;
            PG8_LDB(B0, 1, 0); PG8_SCHED; PG8_LDA(At, 1, 0); PG8_STAGE(PG8_SA(0, 1), a2 + hstep, voffA);
            PG8_WAIT_L(8); PG8_BAR; PG8_WAIT_L(0); PG8_MMA(0, 0, At, B0); PG8_BAR; PG8_SCHED;
            PG8_LDB(B1, 1, 1); PG8_STAGE(PG8_SB(1, 0), b3, voffB);
            PG8_BAR; PG8_WAIT_L(0); PG8_MMA(0, 1, At, B1); PG8_BAR;
            PG8_LDA(At, 1, 1); PG8_STAGE(PG8_SA(1, 0), a3, voffA);
            PG8_BAR; PG8_WAIT_L(0); PG8_MMA(1, 0, At, B0); PG8_BAR; PG8_SCHED;
            PG8_STAGE(PG8_SB(1, 1), b3 + hstepB, voffB);
            PG8_WAIT_V(6); PG8_BAR; PG8_MMA(1, 1, At, B1); PG8_BAR;
            }
        }
        if constexpr (ALIGN_EPI) { if (wr == 0) PG8_BAR; }
        if constexpr (!Epi::AFTER_DRAIN) { E(acc, cur, wr, wc, fr, fq); S.done(cur); }
        if (!has_next) break;
        {
#pragma unroll
        for (int a = 0; a < 2; ++a)
#pragma unroll
            for (int b = 0; b < 2; ++b)
#pragma unroll
                for (int m = 0; m < 4; ++m)
#pragma unroll
                    for (int n = 0; n < 2; ++n) acc[a][b][m][n] = (f32x4){0.f, 0.f, 0.f, 0.f};
        }
        cur = nxt; cA = nA; cB = nB; ++ui;
        if constexpr (ALIGN_EPI) { if (wr == 1) PG8_BAR; }
    }
    PG8_WAIT_V(0);
    if constexpr (!ALIGN_EPI) { if (wr == 0) PG8_BAR; }
    PG8_BAR;
    if constexpr (Epi::AFTER_DRAIN) { E.fused(acc, cur, wr, wc, fr, fq, lds, wid, lane); S.done(cur); }
#undef PG8_SA
#undef PG8_SB
#undef PG8_STAGE
#undef PG8_LDA
#undef PG8_LDB
#undef PG8_MMA
#undef PG8_WAIT_V
#undef PG8_WAIT_L
#undef PG8_BAR
#undef PG8_SCHED
}
}

#define GAS __attribute__((address_space(1)))
#define LAS __attribute__((address_space(3)))
#define DI __device__ __forceinline__
typedef unsigned short bf16;
typedef unsigned v4u __attribute__((ext_vector_type(4)));
typedef unsigned v2u __attribute__((ext_vector_type(2)));
typedef float f32x4 __attribute__((ext_vector_type(4)));
typedef float f32x2 __attribute__((ext_vector_type(2)));
typedef short bf16x8 __attribute__((ext_vector_type(8)));
#define LDS_WAIT() asm volatile("s_waitcnt lgkmcnt(0)" ::: "memory")
#define VM_WAIT() asm volatile("s_waitcnt vmcnt(0)" ::: "memory")

constexpr int NWAVES = 8, NTHR = 512;
constexpr int DM = 2048, DFF = 5632, NMODV = 9 * DM;
constexpr int CB = 32, CT = 256, LB = 8, LT = 4096;
constexpr int NCTX = CB * CT, NLAT = LB * LT, MTOT = NCTX + NLAT;
constexpr int MG = 8192, NGRP = 5;
constexpr int NINP = 16640, NINR = 16416;
constexpr float EPSF = 1e-6f;
constexpr float QSCALE = 0.08838834764831845f;

constexpr size_t O_X = 0, O_NAK = 83886080ull, O_NAV = 100663296ull, O_GST = 117440512ull, O_DK = 134217728ull, O_DV = 150994944ull, O_END = 167772160ull;

constexpr size_t WT_GU1 = 0, WT_DN1 = WT_GU1 + (size_t)2 * DFF * DM, WT_GU2 = WT_DN1 + (size_t)DM * DFF, WT_DN2 = WT_GU2 + (size_t)2 * DFF * DM,
                 WT_IN = WT_DN2 + (size_t)DM * DFF, WT_BR = WT_IN + (size_t)NINP * DM, WT_OUT = WT_BR + (size_t)3 * DM * 1024, WT_END = WT_OUT + (size_t)DM * DM;

constexpr size_t MiB = 1ull << 20;
constexpr size_t WS_CTL = 0, CTL_ZERO_BYTES = 1 * MiB;
constexpr size_t WS_MOD = 1 * MiB;
constexpr size_t WS_MODP = 3 * MiB;
constexpr size_t WS_ROPE = 14 * MiB;
constexpr size_t WS_CKNA = 16 * MiB, WS_CVNA = 24 * MiB, WS_CKD = 32 * MiB, WS_CVD = 40 * MiB;
constexpr size_t WS_WT = 48 * MiB;
constexpr size_t WS_H = 268 * MiB;
constexpr size_t WS_Y = 428 * MiB;
constexpr size_t WS_ACT = 748 * MiB;
constexpr size_t WS_SEG = 748 * MiB;
constexpr size_t WS_GATES = 908 * MiB;
constexpr size_t WS_AB = 1004 * MiB, WS_BL = 1005 * MiB;
constexpr size_t WS_QN = 1006 * MiB, WS_KN = 1022 * MiB, WS_VN = 1038 * MiB;
constexpr size_t WS_DO = 1054 * MiB;
constexpr size_t WS_OGF = 1086 * MiB, WS_OGB = 1118 * MiB;
constexpr size_t WS_MRG = 1150 * MiB;
constexpr size_t WS_MRGB = 1214 * MiB;
constexpr size_t WS_ONA = 1246 * MiB, WS_OG = 1262 * MiB, WS_OD = 1278 * MiB;
constexpr size_t WS_U = 1294 * MiB;
constexpr size_t WS_WK = 1358 * MiB;
constexpr size_t WS_KDT = 1390 * MiB;
constexpr size_t WS_P = 1422 * MiB;
constexpr size_t WS_GAM = 1454 * MiB;
constexpr size_t WS_DQR = 1456 * MiB, WS_DKR = 1472 * MiB;
constexpr size_t WS_XB = 1488 * MiB;
constexpr size_t WS_QC = 1648 * MiB;
constexpr size_t WS_END = 1680 * MiB;
static_assert(WS_WT + WT_END * 2 <= WS_H, "weights fit");
constexpr size_t SEGSZ = (size_t)MG * 1024;

constexpr int LDS_MISC = 0;
constexpr int LDS_SCR = 1024;
constexpr int LDS_BYTES = 155648;

DI float bf2f(unsigned b) { return __uint_as_float(b << 16); }
DI unsigned f2bf(float f) { unsigned u = __float_as_uint(f); return (u + 0x7fffu + ((u >> 16) & 1u)) >> 16; }
typedef float f32x2c __attribute__((ext_vector_type(2))); typedef __bf16 bf16x2c __attribute__((ext_vector_type(2)));
DI unsigned pk2(float lo, float hi) { const f32x2c v = {lo, hi}; const bf16x2c b = __builtin_convertvector(v, bf16x2c); return __builtin_bit_cast(unsigned, b); }
DI float wave_sum(float v) {
#pragma unroll
    for (int o = 1; o < 64; o <<= 1) v += __shfl_xor(v, o);
    return v;
}
DI float siluf(float x) { return x * __builtin_amdgcn_rcpf(1.f + __expf(-x)); }
DI float sigmf(float x) { return __builtin_amdgcn_rcpf(1.f + __expf(-x)); }
DI void unpack8(const v4u w, float (&f)[8]) {
    f[0] = bf2f(w.x & 0xffffu); f[1] = bf2f(w.x >> 16); f[2] = bf2f(w.y & 0xffffu); f[3] = bf2f(w.y >> 16);
    f[4] = bf2f(w.z & 0xffffu); f[5] = bf2f(w.z >> 16); f[6] = bf2f(w.w & 0xffffu); f[7] = bf2f(w.w >> 16);
}
DI v4u pack8(const float (&f)[8]) { v4u w; w.x = pk2(f[0], f[1]); w.y = pk2(f[2], f[3]); w.z = pk2(f[4], f[5]); w.w = pk2(f[6], f[7]); return w; }

struct Params {
    const float* in[29];
    float* out; unsigned char* ws;
    int s_lo, s_hi;
    int rep[16];
};
#define CAS __attribute__((address_space(4)))
typedef const CAS Params* KP;
#define PIN(i) ((const float*)(const GAS float*)P->in[i])
#define PWS ((unsigned char*)(GAS unsigned char*)P->ws)
#define POUT ((float*)(GAS float*)P->out)
struct Ctx {
    int tid, lane, wave, G, bid;
    int gw, ngw;
    LAS unsigned char* L;
    unsigned char* lg;
};
#define XB_TMO      128
#define XB_XCNT(j)  (256  + 64 * (j))
#define XB_XSUB(j)  (1280 + 64 * (j))
#define XB_XGEN(j)  (2304 + 64 * (j))
#define XB_TOP      3328
#define XB_TOPGEN   3392
#define XCD_BAR_WORDS 3456
#define XB_SPIN_CAP (1u << 18)

__device__ __forceinline__ unsigned xb_ld(unsigned* p)              { return __hip_atomic_load(p, __ATOMIC_RELAXED, __HIP_MEMORY_SCOPE_AGENT); }
__device__ __forceinline__ unsigned xb_add(unsigned* p, unsigned v) { return __hip_atomic_fetch_add(p, v, __ATOMIC_RELAXED, __HIP_MEMORY_SCOPE_AGENT); }
__device__ __forceinline__ unsigned xb_xcc_id() { return (unsigned)__builtin_amdgcn_s_getreg((3 << 11) | 20) & 0xFu; }
#define XB_SPIN(cond, bar) do { unsigned _sp = 0; while (cond) { __builtin_amdgcn_s_sleep(1); \
    if ((++_sp & 255u) == 0u) { if (xb_ld(&(bar)[XB_TMO])) break; if (_sp > XB_SPIN_CAP) { atomicAdd(&(bar)[XB_TMO], 1u); break; } } } } while (0)

struct XcdBarrier {
    unsigned* bar; unsigned x;
    volatile LAS unsigned* st;
};

__device__ __forceinline__ XcdBarrier xcd_barrier_post(unsigned* bar, volatile LAS unsigned* st) {
    XcdBarrier b; b.bar = bar; b.x = xb_xcc_id(); b.st = st;
    if (threadIdx.x == 0) (void)xb_add(&bar[XB_XCNT(b.x)], 1u);
    return b;
}
__device__ __forceinline__ void xcd_barrier_complete(unsigned* bar, unsigned x, unsigned& nloc, unsigned& nx) {
    const unsigned G = gridDim.x * gridDim.y * gridDim.z;
    unsigned sum, cnt, mine, sp = 0u;
    for (;;) {
        sum = 0u; cnt = 0u; mine = 0u;
#pragma unroll
        for (unsigned j = 0; j < 16; ++j) { const unsigned c = xb_ld(&bar[XB_XCNT(j)]); sum += c; cnt += (c > 0u) ? 1u : 0u; mine = (j == x) ? c : mine; }
        if (sum == G) break;
        __builtin_amdgcn_s_sleep(1);
        if ((++sp & 255u) == 0u) { if (xb_ld(&bar[XB_TMO])) break; if (sp > XB_SPIN_CAP) { atomicAdd(&bar[XB_TMO], 1u); break; } }
    }
    nloc = mine > 0u ? mine : 1u; nx = cnt > 0u ? cnt : 1u;
}

__device__ __forceinline__ void xcd_barrier(const XcdBarrier& b) {
    asm volatile("s_waitcnt vmcnt(0)" ::: "memory");
    __syncthreads();
    if (threadIdx.x == 0) {
        unsigned* bar = b.bar;
        __builtin_amdgcn_s_waitcnt(0);
        unsigned nloc = b.st[0], nx = b.st[1];
        if (nloc == 0u) { xcd_barrier_complete(bar, b.x, nloc, nx); b.st[0] = nloc; b.st[1] = nx; }
        const unsigned old = xb_add(&bar[XB_XSUB(b.x)], 1u);
        const unsigned gen = old / nloc;
        if (old + 1u == (gen + 1u) * nloc) {
            __builtin_amdgcn_fence(__ATOMIC_RELEASE, "agent");
            asm volatile("s_waitcnt vmcnt(0)" ::: "memory");
            const unsigned og = xb_add(&bar[XB_TOP], 1u);
            const unsigned tg = og / nx;
            if (og + 1u == (tg + 1u) * nx) xb_add(&bar[XB_TOPGEN], 1u);
            else XB_SPIN(xb_ld(&bar[XB_TOPGEN]) == tg, bar);
            __builtin_amdgcn_fence(__ATOMIC_ACQUIRE, "agent");
            xb_add(&bar[XB_XGEN(b.x)], 1u);
            asm volatile("s_waitcnt vmcnt(0)" ::: "memory");
        } else {
            XB_SPIN(xb_ld(&bar[XB_XGEN(b.x)]) == gen, bar);
            __builtin_amdgcn_fence(__ATOMIC_ACQUIRE, "agent");
            asm volatile("s_waitcnt vmcnt(0)" ::: "memory");
        }
    }
    __syncthreads();
}
typedef pg8::f32x4 accv;
DI unsigned ror8(unsigned v) { return (unsigned)__builtin_amdgcn_update_dpp(0, (int)v, 0x128, 0xf, 0xf, false); }
DI void store_pair(bf16* Cb, size_t ld, int rowbase, int colb, int fr, const v4u p0, const v4u p1) {
    const bool lo = fr < 8;
    v4u snd, rcv;
    snd.x = lo ? p1.x : p0.x; snd.y = lo ? p1.y : p0.y; snd.z = lo ? p1.z : p0.z; snd.w = lo ? p1.w : p0.w;
    rcv.x = ror8(snd.x); rcv.y = ror8(snd.y); rcv.z = ror8(snd.z); rcv.w = ror8(snd.w);
    v4u a, b;
    a.x = lo ? p0.x : rcv.x; a.y = lo ? p0.y : rcv.y; a.z = lo ? p0.z : rcv.z; a.w = lo ? p0.w : rcv.w;
    b.x = lo ? rcv.x : p1.x; b.y = lo ? rcv.y : p1.y; b.z = lo ? rcv.z : p1.z; b.w = lo ? rcv.w : p1.w;
    bf16* pa = Cb + (size_t)(rowbase + (fr & 7)) * ld + colb + (lo ? 0 : 32);
    *(v4u*)pa = a; *(v4u*)(pa + 8 * ld) = b;
}

struct EpiSwiGLU {
    static constexpr bool PERM = true, AFTER_DRAIN = false, CARRY = false;
    bf16* ACT;
    DI void operator()(const accv (&acc)[2][2][4][2], const pg8::Unit& u, int wr, int wc, int fr, int fq) const {
        const int row0 = u.pm * 256 + wr * 64 + fr, col0 = u.pn * 128 + wc * 32 + 8 * fq;
#pragma unroll
        for (int ai = 0; ai < 2; ++ai)
#pragma unroll
            for (int m = 0; m < 4; ++m) {
                bf16* p = ACT + (size_t)(row0 + ai * 128 + m * 16) * DFF + col0;
                const accv g0 = acc[ai][0][m][0], g1 = acc[ai][0][m][1], u0 = acc[ai][1][m][0], u1 = acc[ai][1][m][1];
                float v[8];
#pragma unroll
                for (int i = 0; i < 4; ++i) { v[i] = siluf(g0[i]) * u0[i]; v[4 + i] = siluf(g1[i]) * u1[i]; }
                *(v4u*)p = pack8(v);
            }
    }
};
struct EpiBf16Out {
    static constexpr int PERM = 2; static constexpr bool AFTER_DRAIN = false, CARRY = false;
    bf16* C; int ldc;
    DI void operator()(const accv (&acc)[2][2][4][2], const pg8::Unit& u, int wr, int wc, int fr, int fq) const {
        const int rowb = u.pm * 256 + wr * 64, colb = u.pn * 256 + wc * 64 + 8 * fq;
#pragma unroll
        for (int ai = 0; ai < 2; ++ai)
#pragma unroll
            for (int m = 0; m < 4; ++m) {
                v4u w[2];
#pragma unroll
                for (int bj = 0; bj < 2; ++bj) {
                    const accv v0 = acc[ai][bj][m][0], v1 = acc[ai][bj][m][1];
                    w[bj].x = pk2(v0[0], v0[1]); w[bj].y = pk2(v0[2], v0[3]); w[bj].z = pk2(v1[0], v1[1]); w[bj].w = pk2(v1[2], v1[3]);
                }
                store_pair(C, (size_t)ldc, rowb + ai * 128 + m * 16, colb, fr, w[0], w[1]);
            }
    }
};
struct EpiWin {
    static constexpr int PERM = 2; static constexpr bool AFTER_DRAIN = false, CARRY = false;
    bf16* SEG; bf16* GATES; float* out; int isctx; int layer;
    DI void operator()(const accv (&acc)[2][2][4][2], const pg8::Unit& u, int wr, int wc, int fr, int fq) const {
        const int pn = u.pn, row0 = u.pm * 256 + wr * 64 + fr;
        if (pn < 40) {
            const int seg = pn >> 2, col0 = (pn & 3) * 256 + wc * 64 + 8 * fq;
            bf16* base = SEG + (size_t)seg * SEGSZ;
            float* ob = nullptr;
            if (isctx) { if (seg == 1) ob = out + O_NAK; else if (seg == 2) ob = out + O_NAV; else if (seg == 8) ob = out + O_DK; else if (seg == 9) ob = out + O_DV; }
#pragma unroll
            for (int ai = 0; ai < 2; ++ai)
#pragma unroll
                for (int m = 0; m < 4; ++m) {
                    const int row = row0 + ai * 128 + m * 16;
                    v4u w[2];
#pragma unroll
                    for (int bj = 0; bj < 2; ++bj) {
                        const accv v0 = acc[ai][bj][m][0], v1 = acc[ai][bj][m][1];
                        w[bj].x = pk2(v0[0], v0[1]); w[bj].y = pk2(v0[2], v0[3]); w[bj].z = pk2(v1[0], v1[1]); w[bj].w = pk2(v1[2], v1[3]);
                        if (ob) { float* o = ob + ((size_t)((row >> 8) * 2 + layer) * 256 + (row & 255)) * 1024 + col0 + bj * 32; *(accv*)o = v0; *(accv*)(o + 4) = v1; }
                    }
                    store_pair(base, 1024, row - fr, col0, fr, w[0], w[1]);
                }
        } else {
            v4u* gp = (v4u*)GATES + ((size_t)(u.pm * 24 + (pn - 40)) * 16) * 512 + ((wr * 4 + wc) * 64 + fq * 16 + fr);
#pragma unroll
            for (int ai = 0; ai < 2; ++ai)
#pragma unroll
                for (int m = 0; m < 4; ++m) {
#pragma unroll
                    for (int bj = 0; bj < 2; ++bj) {
                        const accv v0 = acc[ai][bj][m][0], v1 = acc[ai][bj][m][1];
                        float v[8];
#pragma unroll
                        for (int i = 0; i < 4; ++i) { v[i] = sigmf(v0[i]); v[4 + i] = sigmf(v1[i]); }
                        gp[(size_t)((ai * 4 + m) * 2 + bj) * 512] = pack8(v);
                    }
                }
        }
    }
};
struct EpiBranch {
    static constexpr int PERM = 2; static constexpr bool AFTER_DRAIN = false, CARRY = false;
    const bf16* GATES; bf16* MRG; bf16* MRGB;
    DI void operator()(const accv (&acc)[2][2][4][2], const pg8::Unit& u, int wr, int wc, int fr, int fq) const {
        const int b = u.pn >> 3, pn = u.pn & 7, pm = u.pm & 31;
        const int t = (wr * 4 + wc) * 64 + fq * 16 + fr;
        const v4u* gp = (const v4u*)GATES + ((size_t)(pm * 24 + u.pn) * 16) * 512 + t;
        v4u* mp = (v4u*)MRG + ((size_t)(pm * 8 + pn) * 16) * 512 + t;
        const int row0 = pm * 256 + wr * 64 + fr, col0 = pn * 256 + wc * 64 + 8 * fq;
        v4u gq[2][2], mq[2][2];
#define BR_LOAD(slot, grp) do { \
            _Pragma("unroll") for (int p_ = 0; p_ < 2; ++p_) { gq[slot][p_] = gp[(size_t)((grp) * 2 + p_) * 512]; if (b > 0) mq[slot][p_] = mp[(size_t)((grp) * 2 + p_) * 512]; } } while (0)
        BR_LOAD(0, 0);
#pragma unroll
        for (int grp = 0; grp < 8; ++grp) {
            const int ai = grp >> 2, m = grp & 3, row = row0 + ai * 128 + m * 16, s = grp & 1;
            if (grp < 7) { if (s == 0) BR_LOAD(1, grp + 1); else BR_LOAD(0, grp + 1); }
            v4u wq[2];
#pragma unroll
            for (int bj = 0; bj < 2; ++bj) {
                float g[8]; unpack8(gq[s][bj], g);
                const accv v0 = acc[ai][bj][m][0], v1 = acc[ai][bj][m][1];
                float v[8];
#pragma unroll
                for (int i = 0; i < 4; ++i) { v[i] = v0[i] * g[i]; v[4 + i] = v1[i] * g[4 + i]; }
                if (b > 0) { float mm[8]; unpack8(mq[s][bj], mm);
#pragma unroll
                    for (int i = 0; i < 8; ++i) v[i] += mm[i]; }
                wq[bj] = pack8(v);
                if (b < 2) mp[(size_t)(grp * 2 + bj) * 512] = wq[bj];
            }
            if (b == 2) store_pair(MRGB, 2048, row - fr, col0, fr, wq[0], wq[1]);
        }
#undef BR_LOAD
    }
};
struct TrItem { const float* W; bf16* WT; int Nsrc, K, k0, src, dstrow; };
DI void tr_load(const TrItem& t, LAS float* scr, int lane) {
#pragma unroll
    for (int i = 0; i < 8; ++i) {
        const int kk = 8 * i + (lane >> 3), c4 = (lane & 7) * 4;
        f32x4 v = (f32x4){0.f, 0.f, 0.f, 0.f};
        if (t.src >= 0) v = *(const f32x4*)(t.W + (size_t)(t.k0 + kk) * t.Nsrc + t.src + c4);
        scr[kk * 33 + c4] = v[0]; scr[kk * 33 + c4 + 1] = v[1]; scr[kk * 33 + c4 + 2] = v[2]; scr[kk * 33 + c4 + 3] = v[3];
    }
}
DI void tr_store(const TrItem& t, const LAS float* scr, int lane) {
    const int c = lane & 7;
#pragma unroll
    for (int j = 0; j < 4; ++j) {
        const int n = (lane >> 3) + 8 * j; const LAS float* s = scr + (8 * c) * 33 + n;
        v4u o; o.x = pk2(s[0 * 33], s[1 * 33]); o.y = pk2(s[2 * 33], s[3 * 33]); o.z = pk2(s[4 * 33], s[5 * 33]); o.w = pk2(s[6 * 33], s[7 * 33]);
        *(v4u*)(t.WT + (size_t)(t.dstrow + n) * t.K + t.k0 + 8 * c) = o;
    }
}
DI TrItem tr_decode(KP P, int l, int it) {
    constexpr int I_GU = 32 * 352, I_DN = 88 * 64, I_IN = 32 * 520, I_BR = 16 * 64;
    bf16* WT = (bf16*)(PWS + WS_WT);
    TrItem t; int r = it;
    if (r < 2 * I_GU) {
        const int f = r / I_GU; r -= f * I_GU;
        const int kb = r / 352, nb = r % 352, j = nb >> 3, q = nb & 7, hh = q >> 2, qq = q & 3;
        t.W = (f ? PIN(15) : PIN(13)) + (size_t)l * DM * 2 * DFF; t.WT = WT + (f ? WT_GU2 : WT_GU1); t.Nsrc = 2 * DFF; t.K = DM; t.k0 = 64 * kb; t.src = hh * DFF + 128 * j + 32 * qq; t.dstrow = 32 * nb;
        return t;
    }
    r -= 2 * I_GU;
    if (r < 2 * I_DN) {
        const int f = r / I_DN; r -= f * I_DN;
        const int kb = r / 64, nb = r % 64;
        t.W = (f ? PIN(16) : PIN(14)) + (size_t)l * DFF * DM; t.WT = WT + (f ? WT_DN2 : WT_DN1); t.Nsrc = DM; t.K = DFF; t.k0 = 64 * kb; t.src = 32 * nb; t.dstrow = 32 * nb;
        return t;
    }
    r -= 2 * I_DN;
    if (r < I_IN) {
        const int kb = r / 520, nb = r % 520, n0 = 32 * nb;
        t.W = PIN(17) + (size_t)l * DM * NINR; t.WT = WT + WT_IN; t.Nsrc = NINR; t.K = DM; t.k0 = 64 * kb; t.dstrow = n0;
        t.src = n0 < 7168 ? n0 : (n0 < 16384 ? n0 + 32 : (n0 < 16416 ? 7168 + (n0 - 16384) : -1));
        return t;
    }
    r -= I_IN;
    if (r < 3 * I_BR) {
        const int b = r / I_BR; r -= b * I_BR;
        const int kb = r / 64, nb = r % 64;
        t.W = (b == 0 ? PIN(25) : (b == 1 ? PIN(26) : PIN(27))) + (size_t)l * 1024 * DM; t.WT = WT + WT_BR + (size_t)b * DM * 1024; t.Nsrc = DM; t.K = 1024; t.k0 = 64 * kb; t.src = 32 * nb; t.dstrow = 32 * nb;
        return t;
    }
    r -= 3 * I_BR;
    { const int kb = r / 64, nb = r % 64;
      t.W = PIN(28) + (size_t)l * DM * DM; t.WT = WT + WT_OUT; t.Nsrc = DM; t.K = DM; t.k0 = 64 * kb; t.src = 32 * nb; t.dstrow = 32 * nb; }
    return t;
}
DI void step_weights(KP P, const Ctx& C, int l) {
    LAS float* scr = (LAS float*)(C.L + LDS_SCR + C.wave * 17408);
    constexpr int NITEMS = 2 * 32 * 352 + 2 * 88 * 64 + 32 * 520 + 3 * 16 * 64 + 32 * 64;
    for (int it = 2 * C.gw; it < NITEMS; it += 2 * C.ngw) {
        const TrItem t0 = tr_decode(P, l, it); const bool two = it + 1 < NITEMS; const TrItem t1 = tr_decode(P, l, two ? it + 1 : it);
        tr_load(t0, scr, C.lane); if (two) tr_load(t1, scr + 64 * 33 + 64, C.lane);
        LDS_WAIT(); asm volatile("" ::: "memory");
        tr_store(t0, scr, C.lane); if (two) tr_store(t1, scr + 64 * 33 + 64, C.lane);
        LDS_WAIT(); asm volatile("" ::: "memory");
    }
}
DI void step_modpartial(KP P, const Ctx& C) {
    LAS float* sc = (LAS float*)(C.L + LDS_SCR + 140 * 1024);
    float* MODP = (float*)(PWS + WS_MODP);
    for (int task = C.bid; task < 2 * 8 * 36; task += C.G) {
        const int cc = task % 36, p = (task / 36) & 7, l = task / 288;
        __syncthreads();
        for (int e = C.tid; e < 9 * 256; e += NTHR) {
            const int s = e >> 8, k = 256 * p + (e & 255);
            const float cv = s == 0 ? PIN(8)[k] : PIN(7)[(size_t)(s - 1) * DM + k];
            sc[e] = siluf(cv);
        }
        __syncthreads();
        const int j = cc * 512 + C.tid;
        const float* W = PIN(9) + ((size_t)l * DM + 256 * p) * NMODV + j;
        float acc[9];
#pragma unroll
        for (int s = 0; s < 9; ++s) acc[s] = 0.f;
#pragma unroll 8
        for (int k = 0; k < 256; ++k) {
            const float w = W[(size_t)k * NMODV];
#pragma unroll
            for (int s = 0; s < 9; ++s) acc[s] += sc[s * 256 + k] * w;
        }
#pragma unroll
        for (int s = 0; s < 9; ++s) MODP[(((size_t)p * 2 + l) * 9 + s) * NMODV + j] = acc[s];
    }
}
DI void step_modreduce(KP P, const Ctx& C) {
    const float* MODP = (const float*)(PWS + WS_MODP); float* MOD = (float*)(PWS + WS_MOD);
    for (int e = C.bid * NTHR + C.tid; e < 2 * 9 * NMODV; e += C.G * NTHR) {
        const int l = e / (9 * NMODV), j = e % NMODV;
        float a = PIN(10)[(size_t)l * NMODV + j];
#pragma unroll
        for (int p = 0; p < 8; ++p) a += MODP[(size_t)p * 2 * 9 * NMODV + e];
        MOD[e] = a;
    }
}
DI void step_caches(KP P, const Ctx& C) {
    constexpr size_t N8 = 4194304 / 8;
    for (size_t i = (size_t)C.bid * NTHR + C.tid; i < 4 * N8; i += (size_t)C.G * NTHR) {
        const int w = (int)(i / N8); const size_t j = i % N8;
        const float* src = (w == 0 ? PIN(2) : (w == 1 ? PIN(3) : (w == 2 ? PIN(5) : PIN(6)))) + j * 8;
        bf16* dst = (bf16*)(PWS + (w == 0 ? WS_CKNA : (w == 1 ? WS_CVNA : (w == 2 ? WS_CKD : WS_CVD)))) + j * 8;
        const f32x4 a = *(const f32x4*)src, b = *(const f32x4*)(src + 4);
        v4u o; o.x = pk2(a[0], a[1]); o.y = pk2(a[2], a[3]); o.z = pk2(b[0], b[1]); o.w = pk2(b[2], b[3]);
        *(v4u*)dst = o;
    }
    if (C.bid == 0) {
        float* R = (float*)(PWS + WS_ROPE);
        for (int e = C.tid; e < 64 * 32; e += NTHR) {
            const int pos = e >> 5, i = e & 31;
            const float inv = powf(10000.0f, -(float)i / 32.0f), ang = (float)pos * inv;
            R[2 * e] = cosf(ang); R[2 * e + 1] = sinf(ang);
        }
    }
}
template <int XSRC  , int XF32  >
DI void step_rows(KP P, const Ctx& C, int l, int post, float coef, int lp, int pre) {
    float* X = POUT; bf16* XB = (bf16*)(PWS + WS_XB); const bf16* Y = (const bf16*)(PWS + WS_Y); bf16* H = (bf16*)(PWS + WS_H);
    const float* MOD = (const float*)(PWS + WS_MOD);
    const int rpb = (MTOT + C.G - 1) / C.G, r0 = C.bid * rpb, r1 = min(r0 + rpb, MTOT);
    LAS float* vw = (LAS float*)(C.L + LDS_SCR);
    const int setA = r0 < NCTX ? 0 : 1 + ((r0 - NCTX) >> 12);
    __syncthreads();
    if (r0 < r1) {
        const int setB = (r1 - 1) < NCTX ? 0 : 1 + ((r1 - 1 - NCTX) >> 12);
        for (int e = C.tid; e < 8 * 512; e += NTHR) {
            const int v = e >> 9, c4 = (e & 511) * 4;
            const float* src;
            if (v == 0) src = PIN(12) + (size_t)(l * 3 + (post < 0 ? 0 : post)) * DM;
            else if (v == 1) src = PIN(11) + (size_t)(lp * 3 + (pre < 0 ? 0 : pre)) * DM;
            else { const int s = (v - 2) / 3, k = (v - 2) % 3, st = s ? setB : setA;
                   src = k == 0 ? MOD + ((size_t)(l * 9 + st) * 9 + 3 * (post < 0 ? 0 : post) + 2) * DM : MOD + ((size_t)(lp * 9 + st) * 9 + 3 * (pre < 0 ? 0 : pre) + (k - 1)) * DM; }
            *(LAS f32x4*)(vw + v * DM + c4) = *(const f32x4*)(src + c4);
        }
    }
    __syncthreads();
    f32x4 xn[8]; v2u xbn[8]; v2u yn[8];
#define ROWS_LOAD(mm) do { const int m_ = (mm); \
        if (XSRC == 1) { const float* src = m_ < NCTX ? PIN(0) + (size_t)m_ * DM : PIN(1) + (size_t)(m_ - NCTX) * DM; \
            _Pragma("unroll") for (int j = 0; j < 8; ++j) xn[j] = *(const f32x4*)(src + 4 * C.lane + 256 * j); } \
        else { const bf16* xr = XB + (size_t)m_ * DM; \
            _Pragma("unroll") for (int j = 0; j < 8; ++j) xbn[j] = *(const v2u*)(xr + 4 * C.lane + 256 * j); } \
        if (post >= 0) { const bf16* yr = Y + (size_t)m_ * DM; \
            _Pragma("unroll") for (int j = 0; j < 8; ++j) yn[j] = *(const v2u*)(yr + 4 * C.lane + 256 * j); } } while (0)
    if (r0 + C.wave < r1) ROWS_LOAD(r0 + C.wave);
    for (int m = r0 + C.wave; m < r1; m += NWAVES) {
        const int set = m < NCTX ? 0 : 1 + ((m - NCTX) >> 12);
        const LAS float* vs = vw + 2 * DM + (set == setA ? 0 : 3 * DM);
        f32x4 xv[8]; v2u yc[8];
#pragma unroll
        for (int j = 0; j < 8; ++j) {
            if (XSRC == 1) xv[j] = xn[j];
            else { const v2u xw = xbn[j]; xv[j][0] = bf2f(xw.x & 0xffffu); xv[j][1] = bf2f(xw.x >> 16); xv[j][2] = bf2f(xw.y & 0xffffu); xv[j][3] = bf2f(xw.y >> 16); }
            yc[j] = yn[j]; }
        if (m + NWAVES < r1) ROWS_LOAD(m + NWAVES);
        if (post >= 0) {
            f32x4 yv[8]; float ss = 0.f;
#pragma unroll
            for (int j = 0; j < 8; ++j) { const v2u yw = yc[j];
                yv[j][0] = bf2f(yw.x & 0xffffu); yv[j][1] = bf2f(yw.x >> 16); yv[j][2] = bf2f(yw.y & 0xffffu); yv[j][3] = bf2f(yw.y >> 16);
                ss += (yv[j][0] * yv[j][0] + yv[j][1] * yv[j][1]) + (yv[j][2] * yv[j][2] + yv[j][3] * yv[j][3]); }
            const float r = rsqrtf(wave_sum(ss) * (1.f / DM) + EPSF) * coef;
#pragma unroll
            for (int j = 0; j < 8; ++j) {
                const f32x4 g = *(const LAS f32x4*)(vs + 4 * C.lane + 256 * j), w = *(const LAS f32x4*)(vw + 4 * C.lane + 256 * j);
                xv[j] = xv[j] + g * (yv[j] * r * w);
            }
            if (XF32) {
                float* xo = X + (size_t)m * DM;
#pragma unroll
                for (int j = 0; j < 8; ++j) *(f32x4*)(xo + 4 * C.lane + 256 * j) = xv[j];
            } else {
                bf16* xo = XB + (size_t)m * DM;
#pragma unroll
                for (int j = 0; j < 8; ++j) { v2u o; o.x = pk2(xv[j][0], xv[j][1]); o.y = pk2(xv[j][2], xv[j][3]); *(v2u*)(xo + 4 * C.lane + 256 * j) = o; }
            }
        }
        if (pre >= 0) {
            float ss = 0.f;
#pragma unroll
            for (int j = 0; j < 8; ++j) ss += (xv[j][0] * xv[j][0] + xv[j][1] * xv[j][1]) + (xv[j][2] * xv[j][2] + xv[j][3] * xv[j][3]);
            const float r = rsqrtf(wave_sum(ss) * (1.f / DM) + EPSF);
            bf16* ho = H + (size_t)m * DM;
#pragma unroll
            for (int j = 0; j < 8; ++j) {
                const f32x4 sh = *(const LAS f32x4*)(vs + DM + 4 * C.lane + 256 * j), sc = *(const LAS f32x4*)(vs + 2 * DM + 4 * C.lane + 256 * j), w = *(const LAS f32x4*)(vw + DM + 4 * C.lane + 256 * j);
                const f32x4 h = (xv[j] * r * w) * (sc + 1.f) + sh;
                v2u o; o.x = pk2(h[0], h[1]); o.y = pk2(h[2], h[3]);
                *(v2u*)(ho + 4 * C.lane + 256 * j) = o;
            }
        }
    }
#undef ROWS_LOAD
}
DI void step_prep(KP P, const Ctx& C, int l, int g) {
    const bf16* SEG = (const bf16*)(PWS + WS_SEG);
    const int T = g == 0 ? CT : LT;
    LAS float* cw = (LAS float*)(C.L + LDS_SCR);
    __syncthreads();
    for (int e = C.tid; e < 9216; e += NTHR) cw[e] = PIN(19)[(size_t)l * 9216 + e];
    __syncthreads();
    float* BL = (float*)(PWS + WS_BL);
    {
        typedef float f32x4t __attribute__((ext_vector_type(4)));
        const int r16 = C.lane & 15, quad = C.lane >> 4;
        LAS f32x4t* part = (LAS f32x4t*)(C.L + LDS_SCR + 40960);
        const bf16* Hg = (const bf16*)(PWS + WS_H) + (size_t)g * MG * DM; const bf16* Wab = (const bf16*)(PWS + WS_WT) + WT_IN + (size_t)16384 * DM;
        for (int task = C.bid; task < MG / 16; task += C.G) {
            const bf16* ap = Hg + (size_t)(16 * task + r16) * DM + 256 * C.wave + 8 * quad; const bf16* b0 = Wab + (size_t)r16 * DM + 256 * C.wave + 8 * quad; const bf16* b1 = b0 + (size_t)16 * DM;
            bf16x8 av[8], bv0[8], bv1[8];
#pragma unroll
            for (int kk = 0; kk < 8; ++kk) { av[kk] = *(const bf16x8*)(ap + 32 * kk); bv0[kk] = *(const bf16x8*)(b0 + 32 * kk); bv1[kk] = *(const bf16x8*)(b1 + 32 * kk); }
            f32x4t a0 = (f32x4t){0.f, 0.f, 0.f, 0.f}, a1 = a0;
#pragma unroll
            for (int kk = 0; kk < 8; ++kk) { a0 = __builtin_amdgcn_mfma_f32_16x16x32_bf16(av[kk], bv0[kk], a0, 0, 0, 0); a1 = __builtin_amdgcn_mfma_f32_16x16x32_bf16(av[kk], bv1[kk], a1, 0, 0, 0); }
            __syncthreads();
            part[(C.wave * 2 + 0) * 64 + C.lane] = a0; part[(C.wave * 2 + 1) * 64 + C.lane] = a1;
            __syncthreads();
            if (C.wave < 2) {
                f32x4t s = part[C.wave * 64 + C.lane];
#pragma unroll
                for (int ww = 1; ww < 8; ++ww) s = s + part[(ww * 2 + C.wave) * 64 + C.lane];
                const float alog = PIN(20)[l * 16 + r16], dtb = PIN(21)[l * 16 + r16];
#pragma unroll
                for (int j = 0; j < 4; ++j) {
                    const int row = 16 * task + 4 * quad + j;
                    if (C.wave == 0) BL[(size_t)row * 32 + r16] = sigmf(s[j]);
                    else { const float xa = s[j] + dtb, sp = fmaxf(xa, 0.f) + log1pf(__expf(-fabsf(xa))); BL[(size_t)row * 32 + 16 + r16] = -__expf(alog) * sp; }
                }
            }
        }
    }
    for (int r0 = 4 * C.gw; r0 < MG; r0 += 4 * C.ngw) {
        const int t0 = r0 & (T - 1);
        const bool hp = t0 > 0, hn = (t0 + 3) < T - 1;
        const float fp = hp ? 1.f : 0.f, fn = hn ? 1.f : 0.f;
        const int rp = hp ? r0 - 1 : r0, rn = hn ? r0 + 4 : r0 + 3;
        v4u rawA[6][2], rawB[6][2];
#define PREP_LOADSEG(RAW, w_) do { const bf16* sb_ = SEG + (size_t)(3 + (w_)) * SEGSZ + 8 * C.lane; \
            _Pragma("unroll") for (int k = 0; k < 6; ++k) { const int rk = k == 0 ? rp : (k == 5 ? rn : r0 + k - 1); \
                _Pragma("unroll") for (int hf = 0; hf < 2; ++hf) RAW[k][hf] = *(const v4u*)(sb_ + (size_t)rk * 1024 + 512 * hf); } } while (0)
#define PREP_COMPUTE(RAW, w_) do { constexpr int w = (w_); bf16* dstb = (bf16*)(PWS + (w == 0 ? WS_QN : (w == 1 ? WS_KN : WS_VN))) + 8 * C.lane; \
            _Pragma("unroll") for (int r = 0; r < 4; ++r) { const float mp = r == 0 ? fp : 1.f, mn = r == 3 ? fn : 1.f; \
                _Pragma("unroll") for (int hf = 0; hf < 2; ++hf) { \
                    float xp[8], xc[8], xn[8], y[8]; unpack8(RAW[r][hf], xp); unpack8(RAW[r + 1][hf], xc); unpack8(RAW[r + 2][hf], xn); \
                    const int ch = w * 1024 + 512 * hf + 8 * C.lane; float c0[8], c1[8], c2[8]; \
                    _Pragma("unroll") for (int q = 0; q < 2; ++q) { const f32x4 a0 = *(const LAS f32x4*)(cw + ch + 4 * q), a1 = *(const LAS f32x4*)(cw + 3072 + ch + 4 * q), a2 = *(const LAS f32x4*)(cw + 6144 + ch + 4 * q); \
                        _Pragma("unroll") for (int i = 0; i < 4; ++i) { c0[4 * q + i] = a0[i]; c1[4 * q + i] = a1[i]; c2[4 * q + i] = a2[i]; } } \
                    float ss = 0.f; \
                    _Pragma("unroll") for (int i = 0; i < 8; ++i) { const float cv = (mp * xp[i]) * c0[i] + xc[i] * c1[i] + (mn * xn[i]) * c2[i]; y[i] = siluf(cv); ss += y[i] * y[i]; } \
                    if (w < 2) { ss += __shfl_xor(ss, 1); ss += __shfl_xor(ss, 2); ss += __shfl_xor(ss, 4); ss += __shfl_xor(ss, 8); \
                        const float rr = rsqrtf(ss + EPSF) * (w == 0 ? QSCALE : 1.f); \
                        _Pragma("unroll") for (int i = 0; i < 8; ++i) y[i] *= rr; } \
                    *(v4u*)(dstb + (size_t)(r0 + r) * 1024 + 512 * hf) = pack8(y); } } } while (0)
        PREP_LOADSEG(rawA, 0); PREP_LOADSEG(rawB, 1); __builtin_amdgcn_sched_barrier(0);
        PREP_COMPUTE(rawA, 0); __builtin_amdgcn_sched_barrier(0);
        PREP_LOADSEG(rawA, 2); __builtin_amdgcn_sched_barrier(0);
        PREP_COMPUTE(rawB, 1); __builtin_amdgcn_sched_barrier(0);
        PREP_COMPUTE(rawA, 2); __builtin_amdgcn_sched_barrier(0);
        v4u own[4][2][2];
        if (g > 0) {
#pragma unroll
            for (int r = 0; r < 4; ++r)
#pragma unroll
                for (int w = 0; w < 2; ++w)
#pragma unroll
                    for (int hf = 0; hf < 2; ++hf) own[r][w][hf] = *(const v4u*)((const bf16*)(PWS + WS_SEG) + (size_t)(7 + w) * SEGSZ + (size_t)(r0 + r) * 1024 + 512 * hf + 8 * C.lane);
        }
#undef PREP_LOADSEG
#undef PREP_COMPUTE
        if (g > 0) {
            const float* R = (const float*)(PWS + WS_ROPE);
            const int a = (C.lane >> 3) & 1, i0 = 8 * (C.lane & 3);
            const float sgn = ((C.lane >> 2) & 1) ? 1.f : -1.f;
#pragma unroll
            for (int r = 0; r < 4; ++r) {
                const int t = t0 + r, pos = a == 0 ? (t >> 6) : (t & 63);
                float cs[8], sn[8];
#pragma unroll
                for (int k = 0; k < 4; ++k) { const f32x4 v = *(const f32x4*)(R + (size_t)(pos * 32 + i0 + 2 * k) * 2); cs[2 * k] = v[0]; sn[2 * k] = v[1]; cs[2 * k + 1] = v[2]; sn[2 * k + 1] = v[3]; }
#pragma unroll
                for (int w = 0; w < 2; ++w) {
#pragma unroll
                    for (int hf = 0; hf < 2; ++hf) {
                        const size_t off = (size_t)(r0 + r) * 1024 + 512 * hf + 8 * C.lane;
                        const v4u ow = own[r][w][hf];
                        v4u oth; oth.x = __shfl_xor(ow.x, 4); oth.y = __shfl_xor(ow.y, 4); oth.z = __shfl_xor(ow.z, 4); oth.w = __shfl_xor(ow.w, 4);
                        float xo[8], xt[8], y[8]; unpack8(ow, xo); unpack8(oth, xt);
#pragma unroll
                        for (int i = 0; i < 8; ++i) y[i] = xo[i] * cs[i] + sgn * (xt[i] * sn[i]);
                        *(v4u*)((bf16*)(PWS + (w == 0 ? WS_DQR : WS_DKR)) + off) = pack8(y);
                    }
                }
            }
        }
    }
}
DI void step_post(KP P, const Ctx& C, int l) {
    const float* OGF = (const float*)(PWS + WS_OGF); const float* OGB = (const float*)(PWS + WS_OGB);
    const bf16* GZ = (const bf16*)(PWS + WS_SEG) + (size_t)6 * SEGSZ; const bf16* DOb = (const bf16*)(PWS + WS_DO);
    bf16* OG = (bf16*)(PWS + WS_OG); bf16* OD = (bf16*)(PWS + WS_OD);
    float lam, lam_init;
    {
        const float* L4 = PIN(23) + (size_t)l * 512;
        const float a = L4[C.lane] * L4[128 + C.lane] + L4[64 + C.lane] * L4[128 + 64 + C.lane];
        const float b = L4[256 + C.lane] * L4[384 + C.lane] + L4[256 + 64 + C.lane] * L4[384 + 64 + C.lane];
        lam_init = 0.8f - 0.6f * expf(-0.3f * (float)l);
        lam = expf(wave_sum(a)) - expf(wave_sum(b)) + lam_init;
    }
    const int c4 = 4 * C.lane;
    float gw_[4], dw_[4];
#pragma unroll
    for (int i = 0; i < 4; ++i) { gw_[i] = PIN(22)[(size_t)l * 128 + ((c4 + i) & 127)]; dw_[i] = PIN(24)[(size_t)l * 256 + c4 + i] * (1.f - lam_init); }
    f32x4 ofn[4], obn[4]; v2u gzn[4], d0n[4], d1n[4];
#define POST_LOAD(rr) do { const size_t r_ = (size_t)(rr); \
        _Pragma("unroll") for (int q = 0; q < 4; ++q) { \
            ofn[q] = *(const f32x4*)(OGF + r_ * 1024 + 256 * q + c4); obn[q] = *(const f32x4*)(OGB + r_ * 1024 + 256 * q + c4); \
            gzn[q] = *(const v2u*)(GZ + r_ * 1024 + 256 * q + c4); \
            d0n[q] = *(const v2u*)(DOb + r_ * 2048 + 512 * q + c4); d1n[q] = *(const v2u*)(DOb + r_ * 2048 + 512 * q + 256 + c4); } } while (0)
    if (C.gw < MG) POST_LOAD(C.gw);
    for (int row = C.gw; row < MG; row += C.ngw) {
        f32x4 of[4], ob[4]; v2u gz[4], d0[4], d1[4];
#pragma unroll
        for (int q = 0; q < 4; ++q) { of[q] = ofn[q]; ob[q] = obn[q]; gz[q] = gzn[q]; d0[q] = d0n[q]; d1[q] = d1n[q]; }
        POST_LOAD(row + C.ngw < MG ? row + C.ngw : row);
#pragma unroll
        for (int q = 0; q < 4; ++q) {
            const f32x4 o = of[q] + ob[q];
            float ss = (o[0] * o[0] + o[1] * o[1]) + (o[2] * o[2] + o[3] * o[3]);
            ss += __shfl_xor(ss, 1); ss += __shfl_xor(ss, 2); ss += __shfl_xor(ss, 4); ss += __shfl_xor(ss, 8); ss += __shfl_xor(ss, 16);
            const float r = rsqrtf(ss * (1.f / 128.f) + EPSF);
            const v2u zw = gz[q];
            const float z0 = bf2f(zw.x & 0xffffu), z1 = bf2f(zw.x >> 16), z2 = bf2f(zw.y & 0xffffu), z3 = bf2f(zw.y >> 16);
            v2u w; w.x = pk2(o[0] * r * gw_[0] * siluf(z0), o[1] * r * gw_[1] * siluf(z1)); w.y = pk2(o[2] * r * gw_[2] * siluf(z2), o[3] * r * gw_[3] * siluf(z3));
            *(v2u*)(OG + (size_t)row * 1024 + 256 * q + c4) = w;
        }
#pragma unroll
        for (int q = 0; q < 4; ++q) {
            const v2u aw = d0[q], bw = d1[q];
            float o[4];
            o[0] = bf2f(aw.x & 0xffffu) - lam * bf2f(bw.x & 0xffffu); o[1] = bf2f(aw.x >> 16) - lam * bf2f(bw.x >> 16);
            o[2] = bf2f(aw.y & 0xffffu) - lam * bf2f(bw.y & 0xffffu); o[3] = bf2f(aw.y >> 16) - lam * bf2f(bw.y >> 16);
            const float ss = wave_sum((o[0] * o[0] + o[1] * o[1]) + (o[2] * o[2] + o[3] * o[3]));
            const float r = rsqrtf(ss * (1.f / 256.f) + EPSF);
            v2u w; w.x = pk2(o[0] * r * dw_[0], o[1] * r * dw_[1]); w.y = pk2(o[2] * r * dw_[2], o[3] * r * dw_[3]);
            *(v2u*)(OD + (size_t)row * 1024 + 256 * q + c4) = w;
        }
    }
#undef POST_LOAD
}
namespace at2 {
using f32x16 = __attribute__((ext_vector_type(16))) float;
using s16x4  = __attribute__((ext_vector_type(4))) short;
using u32x4  = __attribute__((ext_vector_type(4))) unsigned;
constexpr int D = 128, NW = 8, QBLK = 32, KVBLK = 64, LDX = 1024;
constexpr float SCALE = 0.088388347648318440f, THR = 8.f, INV_SCALE = 11.313708498984761f;

constexpr size_t SHM_V = KVBLK * D * 2, SHM_K = KVBLK * D * 2, SHM_ATTN = 2 * SHM_V + 2 * SHM_K + NW * 64 * 4;
#define KSWZ(row, colB) ((row) * 256 + ((colB) ^ (((row) & 7) << 4)))
#define SBAR() __builtin_amdgcn_sched_barrier(0)
DI int crow(int r, int hi) { return (r & 3) + 8 * (r >> 2) + 4 * hi; }
DI unsigned cvtpk(float lo, float hi) { unsigned r; asm volatile("v_cvt_pk_bf16_f32 %0, %1, %2" : "=v"(r) : "v"(lo), "v"(hi)); return r; }

struct NaMask { int on, r0, kr_lo; const LAS float* bias; };

DI void partialSM(f32x16& p0, f32x16& p1, float& m_reg, float& mn, float& alpha) {
  constexpr float C = SCALE * 1.4426950408889634f;
  float pmax = p0[0];
#pragma unroll
  for (int r = 1; r < 16; ++r) pmax = fmaxf(pmax, p0[r]);
#pragma unroll
  for (int r = 0; r < 16; ++r) pmax = fmaxf(pmax, p1[r]);
  { auto rr = __builtin_amdgcn_permlane32_swap(__float_as_uint(pmax), __float_as_uint(pmax), false, false);
    pmax = fmaxf(__uint_as_float(rr[0]), __uint_as_float(rr[1])); }
  if (__builtin_expect(__all(pmax - m_reg <= THR / SCALE), 1)) { mn = m_reg; alpha = 1.f; }
  else { mn = fmaxf(m_reg, pmax); alpha = __builtin_amdgcn_exp2f((m_reg - mn) * C); m_reg = mn; }
  float mnC = -mn * C;
#pragma unroll
  for (int r = 0; r < 16; ++r) p0[r] = fmaf(p0[r], C, mnC);
#pragma unroll
  for (int r = 0; r < 16; ++r) p1[r] = fmaf(p1[r], C, mnC);
#pragma unroll
  for (int r = 0; r < 16; ++r) p0[r] = __builtin_amdgcn_exp2f(p0[r]);
}
DI void finishSM(f32x16& p0, f32x16& p1, float alpha, float& l_reg, bf16x8& pa0, bf16x8& pa1, bf16x8& pa2, bf16x8& pa3) {
#pragma unroll
  for (int r = 0; r < 16; ++r) p1[r] = __builtin_amdgcn_exp2f(p1[r]);
  float ps = 0;
#pragma unroll
  for (int r = 0; r < 16; ++r) ps += p0[r];
#pragma unroll
  for (int r = 0; r < 16; ++r) ps += p1[r];
  { auto rr = __builtin_amdgcn_permlane32_swap(__float_as_uint(ps), __float_as_uint(ps), false, false);
    ps = __uint_as_float(rr[0]) + __uint_as_float(rr[1]); }
  l_reg = l_reg * alpha + ps;
#define PK4(P, BASE, OUT) do { unsigned a0 = cvtpk(P[BASE + 0], P[BASE + 1]), a1 = cvtpk(P[BASE + 2], P[BASE + 3]);   \
    unsigned b0 = cvtpk(P[BASE + 4], P[BASE + 5]), b1 = cvtpk(P[BASE + 6], P[BASE + 7]);                              \
    auto r0 = __builtin_amdgcn_permlane32_swap(a0, b0, false, false); auto r1 = __builtin_amdgcn_permlane32_swap(a1, b1, false, false); \
    u32x4 w = {r0[0], r1[0], r0[1], r1[1]}; OUT = *reinterpret_cast<bf16x8*>(&w); } while (0)
  PK4(p0, 0, pa0); PK4(p0, 8, pa1); PK4(p1, 0, pa2); PK4(p1, 8, pa3);
#undef PK4
}
template <bool QLDS> DI void qkt(f32x16& p0, f32x16& p1, const bf16* Ks, const bf16x8* qr, const char* qlds, int r32, int hi) {
  p0 = f32x16{}; p1 = f32x16{};
#pragma unroll
  for (int d0 = 0; d0 < 8; ++d0) { int cb = (d0 * 16 + hi * 8) * 2;
    bf16x8 qv; if constexpr (QLDS) qv = *reinterpret_cast<const bf16x8*>(qlds + d0 * 1024); else qv = qr[d0];
    bf16x8 b0 = *reinterpret_cast<const bf16x8*>((const char*)Ks + KSWZ(r32, cb));
    bf16x8 b1 = *reinterpret_cast<const bf16x8*>((const char*)Ks + KSWZ(32 + r32, cb));
    p0 = __builtin_amdgcn_mfma_f32_32x32x16_bf16(b0, qv, p0, 0, 0, 0);
    p1 = __builtin_amdgcn_mfma_f32_32x32x16_bf16(b1, qv, p1, 0, 0, 0); }
}
DI void na_mask(f32x16& p0, f32x16& p1, int jt, int wid, int r32, int hi, const NaMask& mk) {
  if (jt < 4) return;
  const int kr = mk.kr_lo + (jt - 4), r = mk.r0 + (wid >> 1), c = (wid & 1) * 32 + r32;
  const int rs = min(max(r - 4, 0), 56), cs = min(max(c - 8, 0), 48);
  const bool rv = (kr >= rs) && (kr < rs + 8);
  const int dr = rv ? (kr - r + 7) : 0;
  const LAS float* brow = mk.bias + dr * 31 + (15 - c);
#pragma unroll
  for (int i = 0; i < 16; ++i) {
    const int kc0 = crow(i, hi), kc1 = kc0 + 32;
    const bool ok0 = rv && ((unsigned)(kc0 - cs) < 16u), ok1 = rv && ((unsigned)(kc1 - cs) < 16u);
    const float b0 = brow[ok0 ? kc0 : c], b1 = brow[ok1 ? kc1 : c];
    p0[i] = ok0 ? fmaf(b0, INV_SCALE, p0[i]) : -1e30f;
    p1[i] = ok1 ? fmaf(b1, INV_SCALE, p1[i]) : -1e30f;
  }
}
DI int v_st(int k, int c) { const int kk = (k & ~0xC) | ((k & 4) << 1) | ((k & 8) >> 1); return ((kk >> 3) * 4 + (c >> 5)) * 512 + ((kk & 7) * 32 + (c & 31)) * 2; }
DI int v_rd_base(int lane) { return ((lane & 3) << 3) | (((lane >> 2) & 3) << 6) | (((lane >> 4) & 1) << 5) | (((lane >> 5) & 1) << 8); }
constexpr int v_rd_off(int d0, int ks, int half) { return d0 * 512 + ks * 4096 + half * 2048; }
template <int OFF> DI s16x4 tr_read(int vb) {
  s16x4 r; asm volatile("ds_read_b64_tr_b16 %0, %1 offset:%2" : "=&v"(r) : "v"(vb), "i"(OFF) : "memory"); return r;
}
template <int D0> DI void pv_one(f32x16& od, int vb, bf16x8 pa0, bf16x8 pa1, bf16x8 pa2, bf16x8 pa3) {
  const s16x4 l0 = tr_read<v_rd_off(D0, 0, 0)>(vb), h0 = tr_read<v_rd_off(D0, 0, 1)>(vb), l1 = tr_read<v_rd_off(D0, 1, 0)>(vb), h1 = tr_read<v_rd_off(D0, 1, 1)>(vb);
  const s16x4 l2 = tr_read<v_rd_off(D0, 2, 0)>(vb), h2 = tr_read<v_rd_off(D0, 2, 1)>(vb), l3 = tr_read<v_rd_off(D0, 3, 0)>(vb), h3 = tr_read<v_rd_off(D0, 3, 1)>(vb);
  asm volatile("s_waitcnt lgkmcnt(0)" ::: "memory"); SBAR();
#define PK(L, H) (bf16x8){L[0], L[1], L[2], L[3], H[0], H[1], H[2], H[3]}
  od = __builtin_amdgcn_mfma_f32_32x32x16_bf16(pa0, PK(l0, h0), od, 0, 0, 0);
  od = __builtin_amdgcn_mfma_f32_32x32x16_bf16(pa1, PK(l1, h1), od, 0, 0, 0);
  od = __builtin_amdgcn_mfma_f32_32x32x16_bf16(pa2, PK(l2, h2), od, 0, 0, 0);
  od = __builtin_amdgcn_mfma_f32_32x32x16_bf16(pa3, PK(l3, h3), od, 0, 0, 0);
#undef PK
}
DI void pv_d0(f32x16* o, int vb, bf16x8 pa0, bf16x8 pa1, bf16x8 pa2, bf16x8 pa3) {
  pv_one<0>(o[0], vb, pa0, pa1, pa2, pa3); pv_one<1>(o[1], vb, pa0, pa1, pa2, pa3); pv_one<2>(o[2], vb, pa0, pa1, pa2, pa3); pv_one<3>(o[3], vb, pa0, pa1, pa2, pa3);
}

template <bool MASKED, int SDEPTH> DI void attn_body(const bf16* __restrict__ Qb, const bf16* __restrict__ K1, const bf16* __restrict__ V1, int n1,
                  const bf16* __restrict__ K2, const bf16* __restrict__ V2, int n2, bf16* __restrict__ Ob, int ldo, char* lds, const NaMask mk) {
  int tid_l = threadIdx.x; asm volatile("" : "+v"(tid_l));
  const int tid = tid_l, wid = tid >> 6, lane = tid & 63, r32 = lane & 31, hi = lane >> 5;
  bf16* V_lds = (bf16*)lds; bf16* K_lds = (bf16*)(lds + 2 * SHM_V);
  float* ws = (float*)(lds + 2 * SHM_V + 2 * SHM_K) + wid * 64; float* li_l = ws; float* al_l = ws + 32;
  float m_reg = -1e30f, l_reg = 0; f32x16 o[4] = {}; bf16x8 qr[8];
  const bf16* Qw = Qb + (long)(wid * QBLK + r32) * LDX + hi * 8;
  char* qlds = lds + SHM_ATTN + 2048 + wid * 8192 + lane * 16;
#pragma unroll
  for (int d0 = 0; d0 < 8; ++d0) { const bf16x8 qv = *reinterpret_cast<const bf16x8*>(Qw + d0 * 16); if constexpr (MASKED) *reinterpret_cast<bf16x8*>(qlds + d0 * 1024) = qv; else qr[d0] = qv; }
  const int sr = tid >> 4, sc = (tid & 15) * 8, vst0 = v_st(sr, sc), vst1 = v_st(32 + sr, sc);
  const int vb0 = (int)(uintptr_t)V_lds + v_rd_base(lane);
  const unsigned toff = (unsigned)(sr * LDX + sc) * 2u;
  struct { bf16x8 vs0, vs1, ks0, ks1; } sr_[SDEPTH];
#define SLOAD(i, k0) do { const int _k = (k0); const char* _kp = (const char*)(_k < n1 ? K1 + (long)_k * LDX : K2 + (long)(_k - n1) * LDX); const char* _vp = (const char*)(_k < n1 ? V1 + (long)_k * LDX : V2 + (long)(_k - n1) * LDX); \
    sr_[i].vs0 = *reinterpret_cast<const bf16x8*>(_vp + toff); sr_[i].vs1 = *reinterpret_cast<const bf16x8*>(_vp + 65536 + toff); \
    sr_[i].ks0 = *reinterpret_cast<const bf16x8*>(_kp + toff); sr_[i].ks1 = *reinterpret_cast<const bf16x8*>(_kp + 65536 + toff); } while (0)
#define SWRITE(b, i) do { *(bf16x8*)((char*)V_lds + (b) * SHM_V + vst0) = sr_[i].vs0;          \
    *(bf16x8*)((char*)V_lds + (b) * SHM_V + vst1) = sr_[i].vs1; int kc = sc * 2;               \
    *(bf16x8*)((char*)K_lds + (b) * SHM_K + KSWZ(sr, kc)) = sr_[i].ks0;                       \
    *(bf16x8*)((char*)K_lds + (b) * SHM_K + KSWZ(32 + sr, kc)) = sr_[i].ks1; } while (0)
#define SWAIT() do { if constexpr (SDEPTH == 2) asm volatile("s_waitcnt vmcnt(4)" ::: "memory"); else asm volatile("s_waitcnt vmcnt(0)" ::: "memory"); } while (0)
#define RESC(a) do { if (__any((a) < 1.f)) { if (hi == 0) al_l[r32] = (a); asm volatile("s_waitcnt lgkmcnt(0)" ::: "memory"); \
    _Pragma("unroll") for (int d = 0; d < 4; ++d) _Pragma("unroll") for (int r = 0; r < 16; ++r) o[d][r] *= al_l[crow(r, hi)]; } } while (0)
#define MASK(P0, P1, JT) do { if constexpr (MASKED) na_mask(P0, P1, (JT), wid, r32, hi, mk); } while (0)
  f32x16 pA0, pA1, pB0, pB1; float mnA, mnB, alA, alB; bf16x8 pa0, pa1, pa2, pa3; const int NT = (n1 + n2) / KVBLK;
  constexpr int SE = 0, SO = SDEPTH - 1;
  SLOAD(SE, 0); asm volatile("s_waitcnt vmcnt(0)" ::: "memory"); SWRITE(0, SE); __syncthreads();
  qkt<MASKED>(pA0, pA1, K_lds, qr, qlds, r32, hi); MASK(pA0, pA1, 0); partialSM(pA0, pA1, m_reg, mnA, alA);
  SLOAD(SO, KVBLK); if constexpr (SDEPTH == 2) { if (2 < NT) SLOAD(SE, 2 * KVBLK); }
  SWAIT(); SWRITE(1, SO); __syncthreads();
  for (int j = 1; j + 1 < NT; j += 2) {
    SBAR(); qkt<MASKED>(pB0, pB1, (bf16*)((char*)K_lds + SHM_K), qr, qlds, r32, hi); MASK(pB0, pB1, j);
    finishSM(pA0, pA1, alA, l_reg, pa0, pa1, pa2, pa3); SBAR();
    SLOAD(SO, (j + SDEPTH) * KVBLK); SBAR();
    pv_d0(o, vb0, pa0, pa1, pa2, pa3); partialSM(pB0, pB1, m_reg, mnB, alB);
    __syncthreads(); SWAIT(); SWRITE(0, SE);
    RESC(alB); __syncthreads();
    SBAR(); qkt<MASKED>(pA0, pA1, K_lds, qr, qlds, r32, hi); MASK(pA0, pA1, j + 1);
    finishSM(pB0, pB1, alB, l_reg, pa0, pa1, pa2, pa3); SBAR();
    if (SDEPTH == 1 || j + 3 < NT) SLOAD(SE, (j + 1 + SDEPTH) * KVBLK); SBAR();
    pv_d0(o, vb0 + (int)SHM_V, pa0, pa1, pa2, pa3); partialSM(pA0, pA1, m_reg, mnA, alA);
    __syncthreads(); SWAIT(); SWRITE(1, SO);
    RESC(alA); __syncthreads();
  }
  SBAR(); qkt<MASKED>(pB0, pB1, (bf16*)((char*)K_lds + SHM_K), qr, qlds, r32, hi); MASK(pB0, pB1, NT - 1);
  finishSM(pA0, pA1, alA, l_reg, pa0, pa1, pa2, pa3); SBAR();
  pv_d0(o, vb0, pa0, pa1, pa2, pa3); partialSM(pB0, pB1, m_reg, mnB, alB);
  __syncthreads(); RESC(alB);
  finishSM(pB0, pB1, alB, l_reg, pa0, pa1, pa2, pa3); SBAR();
  pv_d0(o, vb0 + (int)SHM_V, pa0, pa1, pa2, pa3);
  if (hi == 0) li_l[r32] = l_reg; asm volatile("s_waitcnt lgkmcnt(0)" ::: "memory");
  float rli[16];
#pragma unroll
  for (int r = 0; r < 16; ++r) rli[r] = __builtin_amdgcn_rcpf(li_l[crow(r, hi)]);
  bf16* Ow = Ob + (long)(wid * QBLK) * ldo;
#pragma unroll
  for (int r = 0; r < 16; ++r) { const int orow = crow(r, hi);
#pragma unroll
    for (int d0 = 0; d0 < 4; ++d0) Ow[(long)orow * ldo + d0 * 32 + r32] = (bf16)f2bf(o[d0][r] * rli[r]); }
#undef SLOAD
#undef SWRITE
#undef SWAIT
#undef RESC
#undef MASK
}
}
typedef float f32x4g __attribute__((ext_vector_type(4)));
DI int gdn_tok(int cg, int i, int dir, int T) {
    const int lc = T == 256 ? 2 : 6, seq = cg >> lc, c = cg & ((1 << lc) - 1);
    return dir ? seq * T + T - 1 - (64 * c + i) : cg * 64 + i;
}
#define CHK_BAR() asm volatile("s_waitcnt lgkmcnt(0)\n\ts_barrier" ::: "memory")
DI void gdn_chunk_loop(KP P, const Ctx& C, int first, int nitems, int stride, int T) {
    constexpr int XS = 272;
    LAS float* X = (LAS float*)(C.L + LDS_SCR);
    LAS float* At = X + 64 * XS;
    LAS float* kf = At + 64 * 64;
    LAS float* gm = kf + 64 * 129;
    LAS bf16* Kb = (LAS bf16*)(gm + 192);
    asm volatile("" : "+v"(X), "+v"(At), "+v"(kf), "+v"(gm), "+v"(Kb));
    const bf16* QN = (const bf16*)(PWS + WS_QN); const bf16* KN = (const bf16*)(PWS + WS_KN); const bf16* VN = (const bf16*)(PWS + WS_VN);
    const float* BL = (const float*)(PWS + WS_BL);
    const int lane = C.lane, r16 = lane & 15, quad = lane >> 4, w = C.wave, sel = w >> 2, rb = w & 3;
    bf16x8 af[4]; v4u kv[4]; float la_r = 0.f, be_r = 0.f;
#define CHK_LOAD(itx) do { const int it_ = (itx), dir_ = it_ & 1, h_ = (it_ >> 1) & 7, cg_ = it_ >> 4; \
        { const size_t ta = (size_t)gdn_tok(cg_, 16 * rb + r16, dir_, T); const bf16* ap = (sel ? QN : KN) + ta * 1024 + h_ * 128 + 8 * quad; \
          _Pragma("unroll") for (int kk = 0; kk < 4; ++kk) af[kk] = *(const bf16x8*)(ap + 32 * kk); } \
        _Pragma("unroll") for (int q = 0; q < 4; ++q) { const int e = C.tid + q * NTHR, ww = e >> 10, i = (e >> 4) & 63, c8 = (e & 15) * 8; \
          const size_t tok = (size_t)gdn_tok(cg_, i, dir_, T); kv[q] = *(const v4u*)((ww == 0 ? KN : VN) + tok * 1024 + h_ * 128 + c8); } \
        if (w == 0) { const size_t tok = (size_t)gdn_tok(cg_, lane, dir_, T); la_r = BL[tok * 32 + 16 + dir_ * 8 + h_]; be_r = BL[tok * 32 + dir_ * 8 + h_]; } } while (0)
    if (first < nitems) CHK_LOAD(first);
    for (int item = first; item < nitems; item += stride) {
        const int dir = item & 1, h = (item >> 1) & 7, cg = item >> 4;
        CHK_BAR();
        if (w == 0) {
            float la = la_r;
#pragma unroll
            for (int o = 1; o < 64; o <<= 1) { const float t = __shfl_up(la, o); if (lane >= o) la += t; }
            gm[lane] = la; gm[64 + lane] = be_r; gm[128 + lane] = __expf(la);
            ((float*)(PWS + WS_GAM))[(((size_t)dir * 128 + cg) * 8 + h) * 64 + lane] = la;
        }
#pragma unroll
        for (int q = 0; q < 2; ++q) { const int e = C.tid + q * NTHR, i = (e >> 4) & 63, c8 = (e & 15) * 8; *(LAS v4u*)(Kb + i * 136 + c8) = kv[q]; }
        CHK_BAR();
        f32x4g acc[4];
        {
            bf16x8 bfr[4][4];
#pragma unroll
            for (int cb = 0; cb < 4; ++cb)
#pragma unroll
                for (int kk = 0; kk < 4; ++kk) bfr[cb][kk] = *(const LAS bf16x8*)(Kb + (16 * cb + r16) * 136 + 32 * kk + 8 * quad);
            asm volatile("s_waitcnt lgkmcnt(0)" ::: "memory"); __builtin_amdgcn_sched_barrier(0);
#pragma unroll
            for (int cb = 0; cb < 4; ++cb) {
                acc[cb] = (f32x4g){0.f, 0.f, 0.f, 0.f};
#pragma unroll
                for (int kk = 0; kk < 4; ++kk) acc[cb] = __builtin_amdgcn_mfma_f32_16x16x32_bf16(af[kk], bfr[cb][kk], acc[cb], 0, 0, 0);
            }
            if (sel) {
                bf16* qc = (bf16*)(PWS + WS_QC) + (((size_t)dir * 128 + cg) * 8 + h) * 8192 + (size_t)(rb * 256 + lane) * 8;
#pragma unroll
                for (int kk = 0; kk < 4; ++kk) *(bf16x8*)(qc + kk * 512) = af[kk];
            }
        }
#pragma unroll
        for (int q = 0; q < 4; ++q) {
            const int e = C.tid + q * NTHR, ww = e >> 10, i = (e >> 4) & 63, c8 = (e & 15) * 8;
            float f[8]; unpack8(kv[q], f);
            const float be = gm[64 + i];
            if (ww == 0) {
                const float s = be * gm[128 + i];
#pragma unroll
                for (int x = 0; x < 8; ++x) { kf[i * 129 + c8 + x] = f[x]; X[i * XS + 128 + c8 + x] = s * f[x]; }
            } else {
#pragma unroll
                for (int x = 0; x < 8; ++x) X[i * XS + c8 + x] = be * f[x];
            }
        }
        {
            bf16* Pg = (bf16*)(PWS + WS_P) + (((size_t)dir * 128 + cg) * 8 + h) * 4096;
#pragma unroll
            for (int cb = 0; cb < 4; ++cb)
#pragma unroll
                for (int j = 0; j < 4; ++j) {
                    const int i = 16 * rb + 4 * quad + j, jc = 16 * cb + r16;
                    const float dec = (jc <= i) ? __expf(gm[i] - gm[jc]) : 0.f;
                    if (sel == 0) At[jc * 64 + i] = (jc < i) ? gm[64 + i] * acc[cb][j] * dec : 0.f;
                    else Pg[((rb * 2 + (cb >> 1)) * 64 + (2 * (cb & 1) + (r16 >> 3)) * 16 + 4 * quad + j) * 8 + (r16 & 7)] = (bf16)f2bf(acc[cb][j] * dec);
                }
        }
        if (item + stride < nitems) CHK_LOAD(item + stride);
        CHK_BAR();
        {
            const int d = C.tid >> 2, i0 = (C.tid & 3) * 16;
            const float gl = gm[63];
            bf16* dst = (bf16*)(PWS + WS_KDT) + (((size_t)dir * 128 + cg) * 8 + h) * 8192; (void)i0;
#pragma unroll
            for (int q = 0; q < 2; ++q) {
                float f[8];
#pragma unroll
                for (int x = 0; x < 8; ++x) { const int i = i0 + 8 * q + x; f[x] = kf[i * 129 + d] * __expf(gl - gm[i]); }
                { const int p = (C.tid & 3) * 2 + q; *(v4u*)(dst + (size_t)((((d >> 4) * 2 + (p >> 2)) * 64 + (p & 3) * 16 + (d & 15)) * 8)) = pack8(f); }
            }
        }
#pragma unroll
        for (int b = 0; b < 4; ++b) {
            if (b > 0) {
                float av[12], bv0[12], bv1[12]; f32x4g r0, r1;
#pragma unroll
                for (int c = 0; c < b; ++c)
#pragma unroll
                    for (int ks = 0; ks < 4; ++ks) {
                        const int kr = 16 * c + 4 * ks + quad;
                        av[4 * c + ks] = -At[kr * 64 + 16 * b + r16]; bv0[4 * c + ks] = X[kr * XS + 32 * w + r16]; bv1[4 * c + ks] = X[kr * XS + 32 * w + 16 + r16];
                    }
#pragma unroll
                for (int j = 0; j < 4; ++j) { r0[j] = X[(16 * b + 4 * quad + j) * XS + 32 * w + r16]; r1[j] = X[(16 * b + 4 * quad + j) * XS + 32 * w + 16 + r16]; }
                asm volatile("s_waitcnt lgkmcnt(0)" ::: "memory"); __builtin_amdgcn_sched_barrier(0);
#pragma unroll
                for (int q = 0; q < 4 * b; ++q) { r0 = __builtin_amdgcn_mfma_f32_16x16x4f32(av[q], bv0[q], r0, 0, 0, 0); r1 = __builtin_amdgcn_mfma_f32_16x16x4f32(av[q], bv1[q], r1, 0, 0, 0); }
#pragma unroll
                for (int j = 0; j < 4; ++j) { X[(16 * b + 4 * quad + j) * XS + 32 * w + r16] = r0[j]; X[(16 * b + 4 * quad + j) * XS + 32 * w + 16 + r16] = r1[j]; }
                CHK_BAR();
            }
            if (C.tid < 256) {
                float ab[4], x[16];
#pragma unroll
                for (int k = 0; k < 4; ++k) ab[k] = At[(16 * b + 4 * k + quad) * 64 + 16 * b + r16];
#pragma unroll
                for (int r = 0; r < 16; ++r) x[r] = X[(16 * b + r) * XS + C.tid];
                asm volatile("s_waitcnt lgkmcnt(0)" ::: "memory");
#pragma unroll
                for (int c = 0; c < 15; ++c)
#pragma unroll
                    for (int r = c + 1; r < 16; ++r) {
                        const float a = __uint_as_float(__builtin_amdgcn_readlane(__float_as_uint(ab[c >> 2]), ((c & 3) << 4) | r));
                        x[r] -= a * x[c];
                    }
#pragma unroll
                for (int r = 1; r < 16; ++r) X[(16 * b + r) * XS + C.tid] = x[r];
            }
            CHK_BAR();
        }
        {
            float* Ug = (float*)(PWS + WS_U) + (((size_t)dir * 128 + cg) * 8 + h) * 8192;
            bf16* Wg = (bf16*)(PWS + WS_WK) + (((size_t)dir * 128 + cg) * 8 + h) * 8192;
#pragma unroll
            for (int q = 0; q < 4; ++q) { const int e = C.tid + q * NTHR, i0_ = 16 * ((e >> 6) & 3) + 4 * ((e >> 4) & 3), c_ = 16 * (e >> 8) + (e & 15);
                f32x4 v; v[0] = X[i0_ * XS + c_]; v[1] = X[(i0_ + 1) * XS + c_]; v[2] = X[(i0_ + 2) * XS + c_]; v[3] = X[(i0_ + 3) * XS + c_];
                *(f32x4*)(Ug + (size_t)e * 4) = v; }
#pragma unroll
            for (int q = 0; q < 2; ++q) { const int e = C.tid + q * NTHR, i = e >> 4, c8 = (e & 15) * 8; float f[8];
#pragma unroll
                for (int x = 0; x < 8; ++x) f[x] = X[i * XS + 128 + c8 + x];
                { const int p = e & 15; *(v4u*)(Wg + (size_t)((((i >> 4) * 4 + (p >> 2)) * 64 + (p & 3) * 16 + (i & 15)) * 8)) = pack8(f); } }
        }
    }
    asm volatile("s_waitcnt lgkmcnt(0)" ::: "memory");
#undef CHK_LOAD
}
#undef CHK_BAR
DI void gdn_scan_item(KP P, const Ctx& C, int item, int T, int l, int g) {
    const int sl = item & 7, dir = (item >> 3) & 1, h = (item >> 4) & 7, seq = item >> 7;
    const int cps = T >> 6, v0 = 16 * sl;
    const int lane = C.lane, r16 = lane & 15, quad = lane >> 4, w = C.wave, rt = w & 3;
    LAS bf16* St = (LAS bf16*)(C.L + LDS_SCR);
    LAS bf16* Wt = St + 16 * 136;
    const bf16* QC = (const bf16*)(PWS + WS_QC);
    const bf16* WKb = (const bf16*)(PWS + WS_WK); const float* Ub = (const float*)(PWS + WS_U); const bf16* Pb = (const bf16*)(PWS + WS_P); const bf16* KDT = (const bf16*)(PWS + WS_KDT);
    const float* GAM = (const float*)(PWS + WS_GAM);
    float* OG = (float*)(PWS + (dir ? WS_OGB : WS_OGF));
    f32x4g sreg;
    {
        const int b = g > 0 ? 2 * (g - 1) + seq : 0;
        const float* S0 = PIN(4) + ((((size_t)b * 2 + l) * 2 + dir) * 8 + h) * 16384;
#pragma unroll
        for (int j = 0; j < 4; ++j) sreg[j] = g > 0 ? S0[(size_t)(16 * w + 4 * quad + j) * 128 + v0 + r16] : 0.f;
    }
    __syncthreads();
    { v2u o; o.x = pk2(sreg[0], sreg[1]); o.y = pk2(sreg[2], sreg[3]); *(LAS v2u*)(St + r16 * 136 + 16 * w + 4 * quad) = o; }
    bf16x8 afs0[4], pfs0[2], kdfs0[2], afs1[4], pfs1[2], kdfs1[2], afs2[4], pfs2[2], kdfs2[2], afs3[4], pfs3[2], kdfs3[2];
    f32x4g x4s0, x4s1, x4s2, x4s3; float egls0, egls1, egls2, egls3;
#define GDN_LOAD(S, cgx) do { const int cg_ = (cgx); \
        const size_t ib_ = ((size_t)dir * 128 + cg_) * 8 + h; \
        const bf16* ap = (w < 4 ? WKb : QC) + ib_ * 8192 + (size_t)(rt * 256 + lane) * 8; \
        _Pragma("unroll") for (int kk = 0; kk < 4; ++kk) af##S[kk] = *(const bf16x8*)(ap + 512 * kk); \
        const bf16* pp = Pb + ib_ * 4096 + (w < 4 ? (size_t)0 : (size_t)(rt * 128 + lane) * 8);     \
        pf##S[0] = *(const bf16x8*)pp; pf##S[1] = *(const bf16x8*)(pp + 512); \
        const float* xp = w < 4 ? Ub + ib_ * 8192 + (size_t)((sl * 4 + rt) * 64 + lane) * 4 : GAM + ib_ * 64 + 16 * rt + 4 * quad; \
        x4##S = *(const f32x4g*)xp; \
        { const bf16* kp = KDT + ib_ * 8192 + (size_t)(w * 128 + lane) * 8; kdf##S[0] = *(const bf16x8*)kp; kdf##S[1] = *(const bf16x8*)(kp + 512); \
          egl##S = GAM[ib_ * 64 + 63]; } } while (0)
#define GDN_BAR() asm volatile("s_waitcnt lgkmcnt(0)\n\ts_barrier" ::: "memory")
#define GDN_BODY(CUR, NXT, cgx, more) do { const int cgb = (cgx); \
        if (more) GDN_LOAD(NXT, cgb + 3); \
        GDN_BAR();                                                  \
        bf16x8 sb[4]; \
        _Pragma("unroll") for (int kk = 0; kk < 4; ++kk) sb[kk] = *(const LAS bf16x8*)(St + r16 * 136 + 32 * kk + 8 * quad); \
        f32x4g acc = (f32x4g){0.f, 0.f, 0.f, 0.f}; \
        _Pragma("unroll") for (int kk = 0; kk < 4; ++kk) acc = __builtin_amdgcn_mfma_f32_16x16x32_bf16(af##CUR[kk], sb[kk], acc, 0, 0, 0); \
        if (w < 4) { const f32x4g wv = x4##CUR - acc; v2u o; o.x = pk2(wv[0], wv[1]); o.y = pk2(wv[2], wv[3]); *(LAS v2u*)(Wt + r16 * 72 + 16 * rt + 4 * quad) = o; } \
        else { _Pragma("unroll") for (int j = 0; j < 4; ++j) acc[j] *= __expf(x4##CUR[j]); } \
        GDN_BAR();                                                  \
        bf16x8 wb[2]; \
        wb[0] = *(const LAS bf16x8*)(Wt + r16 * 72 + 8 * quad); wb[1] = *(const LAS bf16x8*)(Wt + r16 * 72 + 32 + 8 * quad); \
        if (w >= 4) { \
            acc = __builtin_amdgcn_mfma_f32_16x16x32_bf16(pf##CUR[0], wb[0], acc, 0, 0, 0); \
            acc = __builtin_amdgcn_mfma_f32_16x16x32_bf16(pf##CUR[1], wb[1], acc, 0, 0, 0); \
            _Pragma("unroll") for (int j = 0; j < 4; ++j) { const size_t tok = (size_t)gdn_tok(cgb, 16 * rt + 4 * quad + j, dir, T); OG[tok * 1024 + h * 128 + v0 + r16] = acc[j]; } \
        } \
        sreg = sreg * __expf(egl##CUR); \
        sreg = __builtin_amdgcn_mfma_f32_16x16x32_bf16(kdf##CUR[0], wb[0], sreg, 0, 0, 0); \
        sreg = __builtin_amdgcn_mfma_f32_16x16x32_bf16(kdf##CUR[1], wb[1], sreg, 0, 0, 0); \
        { v2u o; o.x = pk2(sreg[0], sreg[1]); o.y = pk2(sreg[2], sreg[3]); *(LAS v2u*)(St + r16 * 136 + 16 * w + 4 * quad) = o; } } while (0)
    GDN_LOAD(s0, seq * cps); GDN_LOAD(s1, seq * cps + 1); GDN_LOAD(s2, seq * cps + 2);
    for (int c = 0; c < cps; c += 4) {
        const int cg = seq * cps + c;
        GDN_BODY(s0, s3, cg, c + 3 < cps);
        GDN_BODY(s1, s0, cg + 1, c + 4 < cps);
        GDN_BODY(s2, s1, cg + 2, c + 5 < cps);
        GDN_BODY(s3, s2, cg + 3, c + 6 < cps);
    }
    asm volatile("s_waitcnt lgkmcnt(0)" ::: "memory");
#undef GDN_BODY
#undef GDN_BAR
#undef GDN_LOAD
    if (g == 0) {
        float* So = POUT + O_GST + ((((size_t)seq * 2 + l) * 2 + dir) * 8 + h) * 16384;
#pragma unroll
        for (int j = 0; j < 4; ++j) So[(size_t)(16 * w + 4 * quad + j) * 128 + v0 + r16] = sreg[j];
    }
}
#ifndef ATT_PLAIN_SDEPTH
#define ATT_PLAIN_SDEPTH 1
#endif
template <int WHICH  > DI void step_mixa(KP P, const Ctx& C, int l, int g) {
    char* lds = (char*)C.lg + LDS_SCR;
    LAS float* biasl = (LAS float*)(C.L + LDS_SCR + at2::SHM_ATTN);
    const bf16* SEG = (const bf16*)(PWS + WS_SEG);
    const bf16 *NAQ = SEG, *NAK = SEG + SEGSZ, *NAV = SEG + 2 * SEGSZ, *DV = SEG + 9 * SEGSZ;
    const bf16 *DQ = g == 0 ? SEG + 7 * SEGSZ : (const bf16*)(PWS + WS_DQR), *DK = g == 0 ? SEG + 8 * SEGSZ : (const bf16*)(PWS + WS_DKR);
    bf16* DOb = (bf16*)(PWS + WS_DO); bf16* ONA = (bf16*)(PWS + WS_ONA);
    const bf16 *CKNA = (const bf16*)(PWS + WS_CKNA), *CVNA = (const bf16*)(PWS + WS_CVNA), *CKD = (const bf16*)(PWS + WS_CKD), *CVD = (const bf16*)(PWS + WS_CVD);
    if constexpr (WHICH < 2) {
    const int u_lo = WHICH == 0 ? 0 : 512, u_hi = WHICH == 0 ? (g == 0 ? 768 : 512) : (g == 0 ? 512 : 768);
    for (int u = u_lo + C.bid; u < u_hi; u += C.G) {
        __syncthreads();
        at2::NaMask mk; mk.on = 0; mk.r0 = 0; mk.kr_lo = 0; mk.bias = biasl;
        const bf16 *Q, *K1, *V1, *K2, *V2; bf16* O; int n1, n2, ldo;
        if (g == 0) {
            if (u < 512) {
                const int ph = u & 15, b = u >> 4, hm = ph >> 1, h = ph >> 2, half = ph & 1;
                Q = DQ + (size_t)(b * 256) * 1024 + hm * 128; K1 = DK + (size_t)(b * 256) * 1024 + hm * 128; V1 = DV + (size_t)(b * 256) * 1024 + h * 256 + half * 128;
                n1 = 256; n2 = 0; K2 = K1; V2 = V1; O = DOb + (size_t)(b * 256) * 2048 + ph * 128; ldo = 2048;
            } else {
                const int u2 = u - 512, h = u2 & 7, b = u2 >> 3;
                Q = NAQ + (size_t)(b * 256) * 1024 + h * 128; K1 = NAK + (size_t)(b * 256) * 1024 + h * 128; V1 = NAV + (size_t)(b * 256) * 1024 + h * 128;
                n1 = 256; n2 = 0; K2 = K1; V2 = V1; O = ONA + (size_t)(b * 256) * 1024 + h * 128; ldo = 1024;
            }
        } else {
            if (u < 512) {
                int qb = u & 15, ph = (u >> 4) & 15, bl = u >> 8;
                if (C.G == 256) { const int x_ = C.bid & 7, j_ = C.bid >> 3; bl = u >> 8; ph = 2 * x_ + (j_ >> 4); qb = j_ & 15; }
                const int b = 2 * (g - 1) + bl, hm = ph >> 1, h = ph >> 2, half = ph & 1;
                Q = DQ + (size_t)(bl * 4096 + qb * 256) * 1024 + hm * 128;
                K1 = DK + (size_t)(bl * 4096) * 1024 + hm * 128; V1 = DV + (size_t)(bl * 4096) * 1024 + h * 256 + half * 128; n1 = 4096;
                K2 = CKD + (size_t)((b * 2 + l) * 256) * 1024 + hm * 128; V2 = CVD + (size_t)((b * 2 + l) * 256) * 1024 + h * 256 + half * 128; n2 = 256;
                O = DOb + (size_t)(bl * 4096 + qb * 256) * 2048 + ph * 128; ldo = 2048;
            } else {
                const int u2 = u - 512; int qb = u2 & 15, h = (u2 >> 4) & 7, bl = u2 >> 7;
                if (C.G == 256) { const int x_ = C.bid & 7, j_ = C.bid >> 3; h = x_; bl = j_ >> 4; qb = j_ & 15; }
                const int b = 2 * (g - 1) + bl;
                const int r0 = 4 * qb;
                int kr_lo = min(max(r0 - 4, 0), 56), kr_hi = min(max(r0 - 1, 0), 56) + 8;
                if ((kr_hi - kr_lo) & 1) { if (kr_hi < 64) ++kr_hi; else --kr_lo; }
                Q = NAQ + (size_t)(bl * 4096 + qb * 256) * 1024 + h * 128;
                K1 = CKNA + (size_t)((b * 2 + l) * 256) * 1024 + h * 128; V1 = CVNA + (size_t)((b * 2 + l) * 256) * 1024 + h * 128; n1 = 256;
                K2 = NAK + (size_t)(bl * 4096 + kr_lo * 64) * 1024 + h * 128; V2 = NAV + (size_t)(bl * 4096 + kr_lo * 64) * 1024 + h * 128; n2 = 64 * (kr_hi - kr_lo);
                O = ONA + (size_t)(bl * 4096 + qb * 256) * 1024 + h * 128; ldo = 1024;
                mk.on = 1; mk.r0 = r0; mk.kr_lo = kr_lo;
                { int e = threadIdx.x; asm volatile("" : "+v"(e)); if (e < 465) biasl[e] = PIN(18)[(size_t)(l * 8 + h) * 465 + e]; }
            }
        }
        at2::attn_body<WHICH == 1, (WHICH == 1 ? 1 : ATT_PLAIN_SDEPTH)>(Q, K1, V1, n1, K2, V2, n2, O, ldo, lds, mk);
    }
    } else {
    const int T = g == 0 ? CT : LT;
    __syncthreads();
    gdn_chunk_loop(P, C, C.bid, 2048, C.G, T);
    __syncthreads();
    }
}


struct BranchOrder {
    pg8::StaticOrder S0;
    DI bool next(int i, pg8::Unit& u) const { const int r = i / 3, b = i - 3 * r; pg8::Unit t; if (!S0.next(r, t)) return false; u.pm = 32 * b + t.pm; u.pn = 8 * b + t.pn; return true; }
    DI void a_ready(const pg8::Unit&) const {}
    DI void done(const pg8::Unit&) const {}
};
__global__ void __launch_bounds__(NTHR, 2) mk_fwd(Params P0) {
    KP P = (KP)__builtin_amdgcn_kernarg_segment_ptr();
    extern __shared__ __attribute__((aligned(16))) unsigned char lds_raw[];
    volatile LAS unsigned* MISC = (volatile LAS unsigned*)((LAS unsigned char*)lds_raw + LDS_MISC);
    for (int u = threadIdx.x; u < 256; u += NTHR) MISC[u] = 0u;
    __syncthreads();
    unsigned* barw = (unsigned*)(PWS + WS_CTL) + 4096;
#ifndef DUP_GEMM
#define DUP_GEMM 1
#endif
#ifndef DUP_ATTN
#define DUP_ATTN 1
#endif
#ifndef DUP_GDN
#define DUP_GDN 1
#endif
#define LI(x) ({ int v_ = (x); asm volatile("" : "+s"(v_)); v_; })
#define STEP_CTX KP P; Ctx C; { KP kp_ = (KP)__builtin_amdgcn_kernarg_segment_ptr(); asm volatile("" : "+s"(kp_)); P = kp_; \
    int t_ = threadIdx.x, b_ = blockIdx.x; asm volatile("" : "+v"(t_)); asm volatile("" : "+s"(b_)); \
    C.tid = t_; C.lane = t_ & 63; C.wave = __builtin_amdgcn_readfirstlane(t_ >> 6); C.G = gridDim.x; C.bid = b_; C.gw = C.bid * NWAVES + C.wave; C.ngw = C.G * NWAVES; \
    LAS unsigned char* lp_ = (LAS unsigned char*)lds_raw; asm volatile("" : "+s"(lp_)); C.L = lp_; C.lg = (unsigned char*)lp_; } \
    PG8_LAS unsigned char* ring = (PG8_LAS unsigned char*)(C.L + LDS_SCR); const bf16* WT = (const bf16*)(PWS + WS_WT); \
    bf16* H = (bf16*)(PWS + WS_H); bf16* Y = (bf16*)(PWS + WS_Y); bf16* ACT = (bf16*)(PWS + WS_ACT); (void)ring; (void)WT; (void)H; (void)Y; (void)ACT;
#if MK_ONE_LAUNCH
    XcdBarrier bar = xcd_barrier_post(barw, MISC + 8);
#define GRID_BAR() do { XcdBarrier b2_ = bar; asm volatile("" : "+s"(b2_.bar)); xcd_barrier(b2_); } while (0)
#define GRID_BAR_F() ([&]() { GRID_BAR(); return 0; }())
#else
#define GRID_BAR() do { } while (0)
#define GRID_BAR_F() 0
#endif
    const int s_lo = P->s_lo, s_hi = P->s_hi;
    int step = 0;
#define RUN (step >= s_lo && step < s_hi)
#define REPFOR(k) for (int r_ = 0, n_ = RUN ? P->rep[k] : 0; r_ < n_; ++r_) if (r_ > 0 && (GRID_BAR_F(), false)) {} else
#define NEXT do { if (RUN && step + 1 < s_hi) { GRID_BAR(); } ++step; } while (0)

    for (int l = 0; l < 2; ++l) {
        REPFOR(0) { STEP_CTX step_weights(P, C, l); if (l == 0) { step_modpartial(P, C); step_caches(P, C); } __syncthreads(); }
        NEXT;
        if (l == 0) {
            if (RUN) { STEP_CTX step_modreduce(P, C); }
            NEXT;
            REPFOR(1) { STEP_CTX step_rows<1, 0>(P, C, 0, -1, 0.f, 0, 0); }
            NEXT;
        }
        for (int f = 0; f < 2; ++f) {
            REPFOR(2) { STEP_CTX
                pg8::Gemm gm{H, WT + (f ? WT_GU2 : WT_GU1), MTOT, 2 * DFF, DM}; pg8::StaticOrder S; S.init(MTOT, 2 * DFF, C.G, C.bid);
                EpiSwiGLU E{ACT};
                pg8::gemm_phase<EpiSwiGLU, pg8::StaticOrder, true, true>(ring, gm, S, E);
            }
            NEXT;
            REPFOR(3) { STEP_CTX
                pg8::Gemm gm{ACT, WT + (f ? WT_DN2 : WT_DN1), MTOT, DM, DFF}; pg8::StaticOrder S; S.init(MTOT, DM, C.G, C.bid);
                EpiBf16Out E{Y, DM};
                pg8::gemm_phase<EpiBf16Out, pg8::StaticOrder, true, true>(ring, gm, S, E);
            }
            NEXT;
            if (f == 0) {
                if (RUN) { STEP_CTX if (l == 0) step_rows<1, 0>(P, C, l, 0, 0.5f, l, 1); else step_rows<0, 0>(P, C, l, 0, 0.5f, l, 1); }
                NEXT;
                for (int g = 0; g <= NGRP; ++g) {
                    if (g >= 1) {
                    REPFOR(10) { STEP_CTX
                        pg8::Gemm gm{(const bf16*)(PWS + WS_MRGB), WT + WT_OUT, MG, DM, DM}; pg8::StaticOrder S; S.init(MG, DM, C.G, C.bid);
                        EpiBf16Out E{Y + (size_t)(g - 1) * MG * DM, DM};
                        pg8::gemm_phase<EpiBf16Out, pg8::StaticOrder, true, true>(ring, gm, S, E);
                    }
                    }
                    if (g < NGRP) {
                    REPFOR(4) { STEP_CTX
                        pg8::Gemm gm{H + (size_t)g * MG * DM, WT + WT_IN, MG, 16384, DM}; pg8::StaticOrder S; S.init(MG, 16384, C.G, C.bid);
                        EpiWin E{(bf16*)(PWS + WS_SEG), (bf16*)(PWS + WS_GATES), POUT, g == 0 ? 1 : 0, l};
                        pg8::gemm_phase<EpiWin, pg8::StaticOrder, true, true>(ring, gm, S, E);
                    }
                    }
                    NEXT;
                    if (g == NGRP) break;
                    REPFOR(11) { STEP_CTX step_prep(P, C, LI(l), LI(g)); }
                    NEXT;
                    REPFOR(5) { { STEP_CTX step_mixa<0>(P, C, LI(l), LI(g)); } if (g > 0) { STEP_CTX step_mixa<1>(P, C, LI(l), LI(g)); } }
                    REPFOR(6) { STEP_CTX step_mixa<2>(P, C, LI(l), LI(g)); }
                    NEXT;
                    REPFOR(7) { STEP_CTX const int T = g == 0 ? CT : LT, nit = (MG / T) * 128; for (int k_ = C.bid; k_ < nit; k_ += C.G) { const int b_ = k_ & 255, x_ = b_ & 7, j_ = b_ >> 3; const int it = C.G == 256 ? (k_ & ~255) + (((x_ * 4 + (j_ >> 3)) << 3) | (j_ & 7)) : k_; gdn_scan_item(P, C, it, T, LI(l), LI(g)); } }
                    NEXT;
                    REPFOR(8) { STEP_CTX step_post(P, C, LI(l)); }
                    NEXT;
                    REPFOR(9) { STEP_CTX
                        {
                        pg8::Gemm gm{(const bf16*)(PWS + WS_ONA), WT + WT_BR, 3 * MG, 3 * DM, 1024}; BranchOrder S; S.S0.init(MG, DM, C.G, C.bid);
                        EpiBranch E{(const bf16*)(PWS + WS_GATES), (bf16*)(PWS + WS_MRG), (bf16*)(PWS + WS_MRGB)};
                        pg8::gemm_phase<EpiBranch, BranchOrder, true, true>(ring, gm, S, E);
                        }
                    }
                    NEXT;
                }
                if (RUN) { STEP_CTX step_rows<0, 0>(P, C, l, 1, 1.0f, l, 2); }
                NEXT;
            } else {
                if (RUN) { STEP_CTX if (l == 0) step_rows<0, 0>(P, C, l, 2, 0.5f, l + 1, 0); else step_rows<0, 1>(P, C, l, 2, 0.5f, l + 1, -1); }
                NEXT;
            }
        }
    }
    for (int i_ = 0, n_ = (P->rep[12] - 1) * 100; i_ < n_; ++i_) { GRID_BAR(); }
#undef RUN
#undef NEXT
}
constexpr int NSTEPS = 80;

extern "C" void kernel_launch(void* const* d_in, const int* in_sizes, int n_in, void* d_out, int out_size, void* d_ws, size_t ws_size, hipStream_t stream) {
    static int grid = 0;
    if (grid == 0) {
        if (n_in != 29 || (size_t)out_size != O_END || ws_size < WS_END) {
            fprintf(stderr, "kernel_launch: built for 29 inputs, %zu outputs, >= %zu bytes of workspace; got n_in %d out %d ws %zu; nothing launched\n", (size_t)O_END, (size_t)WS_END, n_in, out_size, ws_size);
            grid = -1; return; }
        int dev = 0, cus = 0, per_cu = 0;
        if (hipGetDevice(&dev) != hipSuccess || hipDeviceGetAttribute(&cus, hipDeviceAttributeMultiprocessorCount, dev) != hipSuccess) { grid = -1; return; }
        if (hipFuncSetAttribute((const void*)mk_fwd, hipFuncAttributeMaxDynamicSharedMemorySize, LDS_BYTES) != hipSuccess) { fprintf(stderr, "kernel_launch: hipFuncSetAttribute failed\n"); grid = -1; return; }
        if (hipOccupancyMaxActiveBlocksPerMultiprocessor(&per_cu, (const void*)mk_fwd, NTHR, LDS_BYTES) != hipSuccess || per_cu < 1)
            fprintf(stderr, "kernel_launch: note: occupancy query reports %d workgroups per CU\n", per_cu);
        (void)hipGetLastError();
        grid = cus;
    }
    if (grid < 0) return;
    if (hipMemsetAsync((char*)d_ws + WS_CTL, 0, CTL_ZERO_BYTES, stream) != hipSuccess) { fprintf(stderr, "kernel_launch: memset failed\n"); return; }
    Params p{};
    for (int i = 0; i < 16; ++i) p.rep[i] = 1;
#ifdef PROBE_REP
    p.rep[PROBE_REP] = 2;
#endif
    for (int i = 0; i < 29; ++i) p.in[i] = (const float*)d_in[i];
    p.out = (float*)d_out; p.ws = (unsigned char*)d_ws;
#if MK_ONE_LAUNCH
    p.s_lo = 0; p.s_hi = NSTEPS;
    hipLaunchKernelGGL(mk_fwd, dim3(grid), dim3(NTHR), LDS_BYTES, stream, p);
#else
    for (int s = 0; s < NSTEPS; ++s) { p.s_lo = s; p.s_hi = s + 1; hipLaunchKernelGGL(mk_fwd, dim3(grid), dim3(NTHR), LDS_BYTES, stream, p); }
#endif
    const hipError_t le = hipPeekAtLastError();
    if (le != hipSuccess) fprintf(stderr, "kernel_launch: launch failed: %s\n", hipGetErrorName(le));
}
```

```cpp
#include <hip/hip_runtime.h>
#include <cstdio>
#include <cstdint>
#ifndef MK_ONE_LAUNCH
#define MK_ONE_LAUNCH 1
#endif
#define AT2_SDEPTH 1
namespace pg8 {
#define PG8_LAS __attribute__((address_space(3)))
typedef unsigned short bf16_t;
typedef short bf16x8 __attribute__((ext_vector_type(8)));
typedef float f32x4 __attribute__((ext_vector_type(4)));
typedef unsigned u32x4 __attribute__((ext_vector_type(4)));
constexpr int BM = 256, BK = 64, HALF = 128, HTB = HALF * BK * 2  , STAGE_BYTES = 8 * HTB, NXCD = 8, WGM = 8;

__host__ __device__ __forceinline__ int lds_byte(int r, int c) { const int st = (r >> 4) * 2 + (c >> 5), rr = r & 15, cc = c & 31, ob = rr * 64 + cc * 2; return st * 1024 + (ob ^ (((ob >> 9) & 1) << 5)); }
__host__ __device__ __forceinline__ void stage_rc(int b, int& R, int& C) { const int st = b / 1024, sb = b % 1024, swz = sb ^ (((sb >> 9) & 1) << 5); R = (st >> 1) * 16 + swz / 64; C = (st & 1) * 32 + (swz % 64) / 2; }
__host__ __device__ __forceinline__ int perm32(int rho) { const int n = rho >> 4, i = rho & 15; return 8 * (i >> 2) + 4 * n + (i & 3); }

struct Unit { int pm, pn; };
struct Gemm { const bf16_t* A; const bf16_t* Bt; int M, N, K; };

struct StaticOrder {
    int nM, nN, nwg, G, c;
    __host__ __device__ void init(int M, int N, int G_, int c_) { nM = M / BM; nN = N / BM; nwg = nM * nN; G = G_; c = c_; }
    __host__ __device__ bool next(int i, Unit& u) const {
        const long L = (long)i * G + c; if (L >= nwg) return false;
        int wgid = (int)L; { const int q = nwg / NXCD, r = nwg % NXCD, xcd = wgid % NXCD, off = wgid / NXCD; wgid = (xcd < r ? xcd * (q + 1) : r * (q + 1) + (xcd - r) * q) + off; }
        const int nig = WGM * nN, gid = wgid / nig, fm = gid * WGM, gsz = (nM - fm) < WGM ? (nM - fm) : WGM;
        u.pm = fm + ((wgid % nig) % gsz); u.pn = (wgid % nig) / gsz; return true;
    }
    __device__ __forceinline__ void a_ready(const Unit&) const {}
    __device__ __forceinline__ void done(const Unit&) const {}
};
__device__ __forceinline__ unsigned cvt_pk_bf16(float lo, float hi) { unsigned r; asm volatile("v_cvt_pk_bf16_f32 %0, %1, %2" : "=v"(r) : "v"(lo), "v"(hi)); return r; }
template <class Epi, class Sched, bool ALIGN_EPI = false, bool SP2 = false>
__device__ __forceinline__ void gemm_phase(PG8_LAS unsigned char* lds, const Gemm g, const Sched& S, const Epi& E) {
    int tid_l = threadIdx.x; asm volatile("" : "+v"(tid_l));
    const int tid = tid_l, wid = __builtin_amdgcn_readfirstlane(tid >> 6), lane = tid & 63, wr = wid >> 2, wc = wid & 3, fr = lane & 15, fq = lane >> 4;
    const int K = g.K, nt = K / BK;
    unsigned voffA[2], voffB[2];
#pragma unroll
    for (int i = 0; i < 2; ++i) { int R, C; stage_rc(tid * 16 + i * 8192, R, C); const int Rb = (int)Epi::PERM == 2 ? (64 * (R >> 5) + perm32(R & 31)) : (Epi::PERM ? ((R & ~31) + perm32(R & 31)) : R);
        voffA[i] = (unsigned)(R * K + C) * 2u; voffB[i] = (unsigned)(Rb * K + C) * 2u; }
    const size_t kstep = (size_t)(BK * 2);
    const size_t hstep = (size_t)HALF * K * 2;
    const size_t hstepB = (int)Epi::PERM == 2 ? (size_t)32 * K * 2 : hstep;
    const size_t tstep = 2 * hstep;
    const unsigned ldsw = (unsigned)wid * 1024u;
    const int aoff = lds_byte(wr * 64 + fr, fq * 8), boff = lds_byte(wc * 32 + fr, fq * 8);
#define PG8_SA(b, h) (((b) * 2 + (h)) * HTB)
#define PG8_SB(b, h) ((4 + (b) * 2 + (h)) * HTB)
#define PG8_STAGE(bufoff, gbase, voff) do { _Pragma("unroll") for (int _i = 0; _i < 2; ++_i) \
        __builtin_amdgcn_global_load_lds((const unsigned*)((const char*)(gbase) + (voff)[_i]), (PG8_LAS unsigned*)(lds + (bufoff) + ldsw + _i * 8192), 16, 0, 0); } while (0)
#define PG8_LDA(dst, b, h) do { _Pragma("unroll") for (int m = 0; m < 4; ++m) _Pragma("unroll") for (int k = 0; k < 2; ++k) dst[m][k] = *(const PG8_LAS bf16x8*)(lds + PG8_SA(b, h) + aoff + m * 2048 + k * 1024); } while (0)
#define PG8_LDB(dst, b, h) do { _Pragma("unroll") for (int n = 0; n < 2; ++n) _Pragma("unroll") for (int k = 0; k < 2; ++k) dst[n][k] = *(const PG8_LAS bf16x8*)(lds + PG8_SB(b, h) + boff + n * 2048 + k * 1024); } while (0)
#define PG8_MMA(ai, bj, At, Bt) do { __builtin_amdgcn_s_setprio(1); _Pragma("unroll") for (int m = 0; m < 4; ++m) _Pragma("unroll") for (int n = 0; n < 2; ++n) _Pragma("unroll") for (int k = 0; k < 2; ++k) \
        acc[ai][bj][m][n] = __builtin_amdgcn_mfma_f32_16x16x32_bf16(Bt[n][k], At[m][k], acc[ai][bj][m][n], 0, 0, 0); __builtin_amdgcn_s_setprio(0); } while (0)
#define PG8_WAIT_V(n) asm volatile("s_waitcnt vmcnt(" #n ")" ::: "memory")
#define PG8_WAIT_L(n) asm volatile("s_waitcnt lgkmcnt(" #n ")" ::: "memory")
#define PG8_BAR __builtin_amdgcn_s_barrier()
#define PG8_SCHED __builtin_amdgcn_sched_barrier(0)
    Unit cur, nxt; int ui = 0;
    if (!S.next(0, cur)) return;
    f32x4 acc[2][2][4][2];
#pragma unroll
    for (int a = 0; a < 2; ++a)
#pragma unroll
        for (int b = 0; b < 2; ++b)
#pragma unroll
            for (int m = 0; m < 4; ++m)
#pragma unroll
                for (int n = 0; n < 2; ++n) acc[a][b][m][n] = (f32x4){0.f, 0.f, 0.f, 0.f};
    bf16x8 At[4][2], B0[2][2], B1[2][2];
    const char* cA = (const char*)g.A + (size_t)cur.pm * tstep; const char* cB = (const char*)g.Bt + (size_t)cur.pn * tstep;
    S.a_ready(cur);
    if constexpr (SP2) {
        PG8_STAGE(PG8_SB(0, 0), cB, voffB); PG8_STAGE(PG8_SB(0, 1), cB + hstepB, voffB); PG8_STAGE(PG8_SA(0, 0), cA, voffA); PG8_STAGE(PG8_SA(0, 1), cA + hstep, voffA);
        if (wr == 1) PG8_BAR;
        PG8_WAIT_V(2); PG8_BAR;
        PG8_STAGE(PG8_SB(1, 0), cB + kstep, voffB); PG8_STAGE(PG8_SA(1, 0), cA + kstep, voffA); PG8_STAGE(PG8_SB(1, 1), cB + hstepB + kstep, voffB);
        PG8_WAIT_V(6); PG8_BAR;
    } else {
        PG8_STAGE(PG8_SB(0, 0), cB, voffB); PG8_STAGE(PG8_SA(0, 0), cA, voffA); PG8_STAGE(PG8_SB(0, 1), cB + hstepB, voffB); PG8_STAGE(PG8_SA(0, 1), cA + hstep, voffA);
        if (wr == 1) PG8_BAR;
        PG8_WAIT_V(4); PG8_BAR;
        PG8_STAGE(PG8_SB(1, 0), cB + kstep, voffB); PG8_STAGE(PG8_SA(1, 0), cA + kstep, voffA); PG8_STAGE(PG8_SB(1, 1), cB + hstepB + kstep, voffB);
        PG8_WAIT_V(6); PG8_BAR;
    }
    for (;;) {
        const bool has_next = S.next(ui + 1, nxt);
        const char* nA = has_next ? (const char*)g.A + (size_t)nxt.pm * tstep : cA; const char* nB = has_next ? (const char*)g.Bt + (size_t)nxt.pn * tstep : cB;
        for (int t = 0; t < nt; t += 2) {
            const bool last = (t == nt - 2);
            const char* a1 = cA + (size_t)(t + 1) * kstep;
            const char* a2 = last ? nA : cA + (size_t)(t + 2) * kstep; const char* b2 = last ? nB : cB + (size_t)(t + 2) * kstep;
            const char* a3 = a2 + kstep; const char* b3 = b2 + kstep;
            if (last && has_next) S.a_ready(nxt);
            if constexpr (SP2) {
            PG8_LDB(B0, 0, 0); PG8_LDB(B1, 0, 1); PG8_SCHED; PG8_LDA(At, 0, 0); PG8_STAGE(PG8_SA(1, 1), a1 + hstep, voffA);
            PG8_WAIT_V(8); PG8_WAIT_L(0); PG8_BAR; PG8_MMA(0, 0, At, B0); PG8_MMA(0, 1, At, B1); PG8_BAR; PG8_SCHED;
            PG8_LDA(At, 0, 1); PG8_STAGE(PG8_SB(0, 0), b2, voffB); PG8_STAGE(PG8_SB(0, 1), b2 + hstepB, voffB); PG8_STAGE(PG8_SA(0, 0), a2, voffA);
            PG8_WAIT_V(8); PG8_WAIT_L(0); PG8_BAR; PG8_MMA(1, 0, At, B0); PG8_MMA(1, 1, At, B1); PG8_BAR; PG8_SCHED;
            PG8_LDB(B0, 1, 0); PG8_LDB(B1, 1, 1); PG8_SCHED; PG8_LDA(At, 1, 0); PG8_STAGE(PG8_SA(0, 1), a2 + hstep, voffA);
            PG8_WAIT_V(8); PG8_WAIT_L(0); PG8_BAR; PG8_MMA(0, 0, At, B0); PG8_MMA(0, 1, At, B1); PG8_BAR; PG8_SCHED;
            PG8_LDA(At, 1, 1); PG8_STAGE(PG8_SB(1, 0), b3, voffB); PG8_STAGE(PG8_SB(1, 1), b3 + hstepB, voffB); PG8_STAGE(PG8_SA(1, 0), a3, voffA);
            PG8_WAIT_V(8); PG8_WAIT_L(0); PG8_BAR; PG8_MMA(1, 0, At, B0); PG8_MMA(1, 1, At, B1); PG8_BAR; PG8_SCHED;
            } else {
            PG8_LDB(B0, 0, 0); PG8_SCHED; PG8_LDA(At, 0, 0); PG8_STAGE(PG8_SA(1, 1), a1 + hstep, voffA);
            PG8_WAIT_L(8); PG8_BAR; PG8_WAIT_L(0); PG8_MMA(0, 0, At, B0); PG8_BAR; PG8_SCHED;
            PG8_LDB(B1, 0, 1); PG8_STAGE(PG8_SB(0, 0), b2, voffB);
            PG8_BAR; PG8_WAIT_L(0); PG8_MMA(0, 1, At, B1); PG8_BAR;
            PG8_LDA(At, 0, 1); PG8_STAGE(PG8_SA(0, 0), a2, voffA);
            PG8_BAR; PG8_WAIT_L(0); PG8_MMA(1, 0, At, B0); PG8_BAR; PG8_SCHED;
            PG8_STAGE(PG8_SB(0, 1), b2 + hstepB, voffB);
            PG8_WAIT_V(6); PG8_BAR; PG8_MMA(1, 1, At, B1); PG8_BAR;
            PG8_LDB(B0, 1, 0); PG8_SCHED; PG8_LDA(At, 1, 0); PG8_STAGE(PG8_SA(0, 1), a2 + hstep, voffA);
            PG8_WAIT_L(8); PG8_BAR; PG8_WAIT_L(0); PG8_MMA(0, 0, At, B0); PG8_BAR; PG8_SCHED;
            PG8_LDB(B1, 1, 1); PG8_STAGE(PG8_SB(1, 0), b3, voffB);
            PG8_BAR; PG8_WAIT_L(0); PG8_MMA(0, 1, At, B1); PG8_BAR;
            PG8_LDA(At, 1, 1); PG8_STAGE(PG8_SA(1, 0), a3, voffA);
            PG8_BAR; PG8_WAIT_L(0); PG8_MMA(1, 0, At, B0); PG8_BAR; PG8_SCHED;
            PG8_STAGE(PG8_SB(1, 1), b3 + hstepB, voffB);
            PG8_WAIT_V(6); PG8_BAR; PG8_MMA(1, 1, At, B1); PG8_BAR;
            }
        }
        if constexpr (ALIGN_EPI) { if (wr == 0) PG8_BAR; }
        if constexpr (!Epi::AFTER_DRAIN) { E(acc, cur, wr, wc, fr, fq); S.done(cur); }
        if (!has_next) break;
        {
#pragma unroll
        for (int a = 0; a < 2; ++a)
#pragma unroll
            for (int b = 0; b < 2; ++b)
#pragma unroll
                for (int m = 0; m < 4; ++m)
#pragma unroll
                    for (int n = 0; n < 2; ++n) acc[a][b][m][n] = (f32x4){0.f, 0.f, 0.f, 0.f};
        }
        cur = nxt; cA = nA; cB = nB; ++ui;
        if constexpr (ALIGN_EPI) { if (wr == 1) PG8_BAR; }
    }
    PG8_WAIT_V(0);
    if constexpr (!ALIGN_EPI) { if (wr == 0) PG8_BAR; }
    PG8_BAR;
    if constexpr (Epi::AFTER_DRAIN) { E.fused(acc, cur, wr, wc, fr, fq, lds, wid, lane); S.done(cur); }
#undef PG8_SA
#undef PG8_SB
#undef PG8_STAGE
#undef PG8_LDA
#undef PG8_LDB
#undef PG8_MMA
#undef PG8_WAIT_V
#undef PG8_WAIT_L
#undef PG8_BAR
#undef PG8_SCHED
}
}

#define GAS __attribute__((address_space(1)))
#define LAS __attribute__((address_space(3)))
#define DI __device__ __forceinline__
typedef unsigned short bf16;
typedef unsigned v4u __attribute__((ext_vector_type(4)));
typedef unsigned v2u __attribute__((ext_vector_type(2)));
typedef float f32x4 __attribute__((ext_vector_type(4)));
typedef float f32x2 __attribute__((ext_vector_type(2)));
typedef short bf16x8 __attribute__((ext_vector_type(8)));
#define LDS_WAIT() asm volatile("s_waitcnt lgkmcnt(0)" ::: "memory")
#define VM_WAIT() asm volatile("s_waitcnt vmcnt(0)" ::: "memory")

constexpr int NWAVES = 8, NTHR = 512;
constexpr int DM = 2048, DFF = 5632, NMODV = 9 * DM;
constexpr int CB = 32, CT = 256, LB = 8, LT = 4096;
constexpr int NCTX = CB * CT, NLAT = LB * LT, MTOT = NCTX + NLAT;
constexpr int MG = 8192, NGRP = 5;
constexpr int NINP = 16640, NINR = 16416;
constexpr float EPSF = 1e-6f;
constexpr float QSCALE = 0.08838834764831845f;

constexpr size_t O_X = 0, O_NAK = 83886080ull, O_NAV = 100663296ull, O_GST = 117440512ull, O_DK = 134217728ull, O_DV = 150994944ull, O_END = 167772160ull;

constexpr size_t WT_GU1 = 0, WT_DN1 = WT_GU1 + (size_t)2 * DFF * DM, WT_GU2 = WT_DN1 + (size_t)DM * DFF, WT_DN2 = WT_GU2 + (size_t)2 * DFF * DM,
                 WT_IN = WT_DN2 + (size_t)DM * DFF, WT_BR = WT_IN + (size_t)NINP * DM, WT_OUT = WT_BR + (size_t)3 * DM * 1024, WT_END = WT_OUT + (size_t)DM * DM;

constexpr size_t MiB = 1ull << 20;
constexpr size_t WS_CTL = 0, CTL_ZERO_BYTES = 1 * MiB;
constexpr size_t WS_MOD = 1 * MiB;
constexpr size_t WS_MODP = 3 * MiB;
constexpr size_t WS_ROPE = 14 * MiB;
constexpr size_t WS_CKNA = 16 * MiB, WS_CVNA = 24 * MiB, WS_CKD = 32 * MiB, WS_CVD = 40 * MiB;
constexpr size_t WS_WT = 48 * MiB;
constexpr size_t WS_H = 268 * MiB;
constexpr size_t WS_Y = 428 * MiB;
constexpr size_t WS_ACT = 748 * MiB;
constexpr size_t WS_SEG = 748 * MiB;
constexpr size_t WS_GATES = 908 * MiB;
constexpr size_t WS_AB = 1004 * MiB, WS_BL = 1005 * MiB;
constexpr size_t WS_QN = 1006 * MiB, WS_KN = 1022 * MiB, WS_VN = 1038 * MiB;
constexpr size_t WS_DO = 1054 * MiB;
constexpr size_t WS_OGF = 1086 * MiB, WS_OGB = 1118 * MiB;
constexpr size_t WS_MRG = 1150 * MiB;
constexpr size_t WS_MRGB = 1214 * MiB;
constexpr size_t WS_ONA = 1246 * MiB, WS_OG = 1262 * MiB, WS_OD = 1278 * MiB;
constexpr size_t WS_U = 1294 * MiB;
constexpr size_t WS_WK = 1358 * MiB;
constexpr size_t WS_KDT = 1390 * MiB;
constexpr size_t WS_P = 1422 * MiB;
constexpr size_t WS_GAM = 1454 * MiB;
constexpr size_t WS_DQR = 1456 * MiB, WS_DKR = 1472 * MiB;
constexpr size_t WS_XB = 1488 * MiB;
constexpr size_t WS_QC = 1648 * MiB;
constexpr size_t WS_END = 1680 * MiB;
static_assert(WS_WT + WT_END * 2 <= WS_H, "weights fit");
constexpr size_t SEGSZ = (size_t)MG * 1024;

constexpr int LDS_MISC = 0;
constexpr int LDS_SCR = 1024;
constexpr int LDS_BYTES = 155648;

DI float bf2f(unsigned b) { return __uint_as_float(b << 16); }
DI unsigned f2bf(float f) { unsigned u = __float_as_uint(f); return (u + 0x7fffu + ((u >> 16) & 1u)) >> 16; }
typedef float f32x2c __attribute__((ext_vector_type(2))); typedef __bf16 bf16x2c __attribute__((ext_vector_type(2)));
DI unsigned pk2(float lo, float hi) { const f32x2c v = {lo, hi}; const bf16x2c b = __builtin_convertvector(v, bf16x2c); return __builtin_bit_cast(unsigned, b); }
DI float wave_sum(float v) {
#pragma unroll
    for (int o = 1; o < 64; o <<= 1) v += __shfl_xor(v, o);
    return v;
}
DI float siluf(float x) { return x * __builtin_amdgcn_rcpf(1.f + __expf(-x)); }
DI float sigmf(float x) { return __builtin_amdgcn_rcpf(1.f + __expf(-x)); }
DI void unpack8(const v4u w, float (&f)[8]) {
    f[0] = bf2f(w.x & 0xffffu); f[1] = bf2f(w.x >> 16); f[2] = bf2f(w.y & 0xffffu); f[3] = bf2f(w.y >> 16);
    f[4] = bf2f(w.z & 0xffffu); f[5] = bf2f(w.z >> 16); f[6] = bf2f(w.w & 0xffffu); f[7] = bf2f(w.w >> 16);
}
DI v4u pack8(const float (&f)[8]) { v4u w; w.x = pk2(f[0], f[1]); w.y = pk2(f[2], f[3]); w.z = pk2(f[4], f[5]); w.w = pk2(f[6], f[7]); return w; }

struct Params {
    const float* in[29];
    float* out; unsigned char* ws;
    int s_lo, s_hi;
    int rep[16];
};
#define CAS __attribute__((address_space(4)))
typedef const CAS Params* KP;
#define PIN(i) ((const float*)(const GAS float*)P->in[i])
#define PWS ((unsigned char*)(GAS unsigned char*)P->ws)
#define POUT ((float*)(GAS float*)P->out)
struct Ctx {
    int tid, lane, wave, G, bid;
    int gw, ngw;
    LAS unsigned char* L;
    unsigned char* lg;
};
#define XB_TMO      128
#define XB_XCNT(j)  (256  + 64 * (j))
#define XB_XSUB(j)  (1280 + 64 * (j))
#define XB_XGEN(j)  (2304 + 64 * (j))
#define XB_TOP      3328
#define XB_TOPGEN   3392
#define XCD_BAR_WORDS 3456
#define XB_SPIN_CAP (1u << 18)

__device__ __forceinline__ unsigned xb_ld(unsigned* p)              { return __hip_atomic_load(p, __ATOMIC_RELAXED, __HIP_MEMORY_SCOPE_AGENT); }
__device__ __forceinline__ unsigned xb_add(unsigned* p, unsigned v) { return __hip_atomic_fetch_add(p, v, __ATOMIC_RELAXED, __HIP_MEMORY_SCOPE_AGENT); }
__device__ __forceinline__ unsigned xb_xcc_id() { return (unsigned)__builtin_amdgcn_s_getreg((3 << 11) | 20) & 0xFu; }
#define XB_SPIN(cond, bar) do { unsigned _sp = 0; while (cond) { __builtin_amdgcn_s_sleep(1); \
    if ((++_sp & 255u) == 0u) { if (xb_ld(&(bar)[XB_TMO])) break; if (_sp > XB_SPIN_CAP) { atomicAdd(&(bar)[XB_TMO], 1u); break; } } } } while (0)

struct XcdBarrier {
    unsigned* bar; unsigned x;
    volatile LAS unsigned* st;
};

__device__ __forceinline__ XcdBarrier xcd_barrier_post(unsigned* bar, volatile LAS unsigned* st) {
    XcdBarrier b; b.bar = bar; b.x = xb_xcc_id(); b.st = st;
    if (threadIdx.x == 0) (void)xb_add(&bar[XB_XCNT(b.x)], 1u);
    return b;
}
__device__ __forceinline__ void xcd_barrier_complete(unsigned* bar, unsigned x, unsigned& nloc, unsigned& nx) {
    const unsigned G = gridDim.x * gridDim.y * gridDim.z;
    unsigned sum, cnt, mine, sp = 0u;
    for (;;) {
        sum = 0u; cnt = 0u; mine = 0u;
#pragma unroll
        for (unsigned j = 0; j < 16; ++j) { const unsigned c = xb_ld(&bar[XB_XCNT(j)]); sum += c; cnt += (c > 0u) ? 1u : 0u; mine = (j == x) ? c : mine; }
        if (sum == G) break;
        __builtin_amdgcn_s_sleep(1);
        if ((++sp & 255u) == 0u) { if (xb_ld(&bar[XB_TMO])) break; if (sp > XB_SPIN_CAP) { atomicAdd(&bar[XB_TMO], 1u); break; } }
    }
    nloc = mine > 0u ? mine : 1u; nx = cnt > 0u ? cnt : 1u;
}

__device__ __forceinline__ void xcd_barrier(const XcdBarrier& b) {
    asm volatile("s_waitcnt vmcnt(0)" ::: "memory");
    __syncthreads();
    if (threadIdx.x == 0) {
        unsigned* bar = b.bar;
        __builtin_amdgcn_s_waitcnt(0);
        unsigned nloc = b.st[0], nx = b.st[1];
        if (nloc == 0u) { xcd_barrier_complete(bar, b.x, nloc, nx); b.st[0] = nloc; b.st[1] = nx; }
        const unsigned old = xb_add(&bar[XB_XSUB(b.x)], 1u);
        const unsigned gen = old / nloc;
        if (old + 1u == (gen + 1u) * nloc) {
            __builtin_amdgcn_fence(__ATOMIC_RELEASE, "agent");
            asm volatile("s_waitcnt vmcnt(0)" ::: "memory");
            const unsigned og = xb_add(&bar[XB_TOP], 1u);
            const unsigned tg = og / nx;
            if (og + 1u == (tg + 1u) * nx) xb_add(&bar[XB_TOPGEN], 1u);
            else XB_SPIN(xb_ld(&bar[XB_TOPGEN]) == tg, bar);
            __builtin_amdgcn_fence(__ATOMIC_ACQUIRE, "agent");
            xb_add(&bar[XB_XGEN(b.x)], 1u);
            asm volatile("s_waitcnt vmcnt(0)" ::: "memory");
        } else {
            XB_SPIN(xb_ld(&bar[XB_XGEN(b.x)]) == gen, bar);
            __builtin_amdgcn_fence(__ATOMIC_ACQUIRE, "agent");
            asm volatile("s_waitcnt vmcnt(0)" ::: "memory");
        }
    }
    __syncthreads();
}
typedef pg8::f32x4 accv;
DI unsigned ror8(unsigned v) { return (unsigned)__builtin_amdgcn_update_dpp(0, (int)v, 0x128, 0xf, 0xf, false); }
DI void store_pair(bf16* Cb, size_t ld, int rowbase, int colb, int fr, const v4u p0, const v4u p1) {
    const bool lo = fr < 8;
    v4u snd, rcv;
    snd.x = lo ? p1.x : p0.x; snd.y = lo ? p1.y : p0.y; snd.z = lo ? p1.z : p0.z; snd.w = lo ? p1.w : p0.w;
    rcv.x = ror8(snd.x); rcv.y = ror8(snd.y); rcv.z = ror8(snd.z); rcv.w = ror8(snd.w);
    v4u a, b;
    a.x = lo ? p0.x : rcv.x; a.y = lo ? p0.y : rcv.y; a.z = lo ? p0.z : rcv.z; a.w = lo ? p0.w : rcv.w;
    b.x = lo ? rcv.x : p1.x; b.y = lo ? rcv.y : p1.y; b.z = lo ? rcv.z : p1.z; b.w = lo ? rcv.w : p1.w;
    bf16* pa = Cb + (size_t)(rowbase + (fr & 7)) * ld + colb + (lo ? 0 : 32);
    *(v4u*)pa = a; *(v4u*)(pa + 8 * ld) = b;
}

struct EpiSwiGLU {
    static constexpr bool PERM = true, AFTER_DRAIN = false, CARRY = false;
    bf16* ACT;
    DI void operator()(const accv (&acc)[2][2][4][2], const pg8::Unit& u, int wr, int wc, int fr, int fq) const {
        const int row0 = u.pm * 256 + wr * 64 + fr, col0 = u.pn * 128 + wc * 32 + 8 * fq;
#pragma unroll
        for (int ai = 0; ai < 2; ++ai)
#pragma unroll
            for (int m = 0; m < 4; ++m) {
                bf16* p = ACT + (size_t)(row0 + ai * 128 + m * 16) * DFF + col0;
                const accv g0 = acc[ai][0][m][0], g1 = acc[ai][0][m][1], u0 = acc[ai][1][m][0], u1 = acc[ai][1][m][1];
                float v[8];
#pragma unroll
                for (int i = 0; i < 4; ++i) { v[i] = siluf(g0[i]) * u0[i]; v[4 + i] = siluf(g1[i]) * u1[i]; }
                *(v4u*)p = pack8(v);
            }
    }
};
struct EpiBf16Out {
    static constexpr int PERM = 2; static constexpr bool AFTER_DRAIN = false, CARRY = false;
    bf16* C; int ldc;
    DI void operator()(const accv (&acc)[2][2][4][2], const pg8::Unit& u, int wr, int wc, int fr, int fq) const {
        const int rowb = u.pm * 256 + wr * 64, colb = u.pn * 256 + wc * 64 + 8 * fq;
#pragma unroll
        for (int ai = 0; ai < 2; ++ai)
#pragma unroll
            for (int m = 0; m < 4; ++m) {
                v4u w[2];
#pragma unroll
                for (int bj = 0; bj < 2; ++bj) {
                    const accv v0 = acc[ai][bj][m][0], v1 = acc[ai][bj][m][1];
                    w[bj].x = pk2(v0[0], v0[1]); w[bj].y = pk2(v0[2], v0[3]); w[bj].z = pk2(v1[0], v1[1]); w[bj].w = pk2(v1[2], v1[3]);
                }
                store_pair(C, (size_t)ldc, rowb + ai * 128 + m * 16, colb, fr, w[0], w[1]);
            }
    }
};
struct EpiWin {
    static constexpr int PERM = 2; static constexpr bool AFTER_DRAIN = false, CARRY = false;
    bf16* SEG; bf16* GATES; float* out; int isctx; int layer;
    DI void operator()(const accv (&acc)[2][2][4][2], const pg8::Unit& u, int wr, int wc, int fr, int fq) const {
        const int pn = u.pn, row0 = u.pm * 256 + wr * 64 + fr;
        if (pn < 40) {
            const int seg = pn >> 2, col0 = (pn & 3) * 256 + wc * 64 + 8 * fq;
            bf16* base = SEG + (size_t)seg * SEGSZ;
            float* ob = nullptr;
            if (isctx) { if (seg == 1) ob = out + O_NAK; else if (seg == 2) ob = out + O_NAV; else if (seg == 8) ob = out + O_DK; else if (seg == 9) ob = out + O_DV; }
#pragma unroll
            for (int ai = 0; ai < 2; ++ai)
#pragma unroll
                for (int m = 0; m < 4; ++m) {
                    const int row = row0 + ai * 128 + m * 16;
                    v4u w[2];
#pragma unroll
                    for (int bj = 0; bj < 2; ++bj) {
                        const accv v0 = acc[ai][bj][m][0], v1 = acc[ai][bj][m][1];
                        w[bj].x = pk2(v0[0], v0[1]); w[bj].y = pk2(v0[2], v0[3]); w[bj].z = pk2(v1[0], v1[1]); w[bj].w = pk2(v1[2], v1[3]);
                        if (ob) { float* o = ob + ((size_t)((row >> 8) * 2 + layer) * 256 + (row & 255)) * 1024 + col0 + bj * 32; *(accv*)o = v0; *(accv*)(o + 4) = v1; }
                    }
                    store_pair(base, 1024, row - fr, col0, fr, w[0], w[1]);
                }
        } else {
            v4u* gp = (v4u*)GATES + ((size_t)(u.pm * 24 + (pn - 40)) * 16) * 512 + ((wr * 4 + wc) * 64 + fq * 16 + fr);
#pragma unroll
            for (int ai = 0; ai < 2; ++ai)
#pragma unroll
                for (int m = 0; m < 4; ++m) {
#pragma unroll
                    for (int bj = 0; bj < 2; ++bj) {
                        const accv v0 = acc[ai][bj][m][0], v1 = acc[ai][bj][m][1];
                        float v[8];
#pragma unroll
                        for (int i = 0; i < 4; ++i) { v[i] = sigmf(v0[i]); v[4 + i] = sigmf(v1[i]); }
                        gp[(size_t)((ai * 4 + m) * 2 + bj) * 512] = pack8(v);
                    }
                }
        }
    }
};
struct EpiBranch {
    static constexpr int PERM = 2; static constexpr bool AFTER_DRAIN = false, CARRY = false;
    const bf16* GATES; bf16* MRG; bf16* MRGB;
    DI void operator()(const accv (&acc)[2][2][4][2], const pg8::Unit& u, int wr, int wc, int fr, int fq) const {
        const int b = u.pn >> 3, pn = u.pn & 7, pm = u.pm & 31;
        const int t = (wr * 4 + wc) * 64 + fq * 16 + fr;
        const v4u* gp = (const v4u*)GATES + ((size_t)(pm * 24 + u.pn) * 16) * 512 + t;
        v4u* mp = (v4u*)MRG + ((size_t)(pm * 8 + pn) * 16) * 512 + t;
        const int row0 = pm * 256 + wr * 64 + fr, col0 = pn * 256 + wc * 64 + 8 * fq;
        v4u gq[2][2], mq[2][2];
#define BR_LOAD(slot, grp) do { \
            _Pragma("unroll") for (int p_ = 0; p_ < 2; ++p_) { gq[slot][p_] = gp[(size_t)((grp) * 2 + p_) * 512]; if (b > 0) mq[slot][p_] = mp[(size_t)((grp) * 2 + p_) * 512]; } } while (0)
        BR_LOAD(0, 0);
#pragma unroll
        for (int grp = 0; grp < 8; ++grp) {
            const int ai = grp >> 2, m = grp & 3, row = row0 + ai * 128 + m * 16, s = grp & 1;
            if (grp < 7) { if (s == 0) BR_LOAD(1, grp + 1); else BR_LOAD(0, grp + 1); }
            v4u wq[2];
#pragma unroll
            for (int bj = 0; bj < 2; ++bj) {
                float g[8]; unpack8(gq[s][bj], g);
                const accv v0 = acc[ai][bj][m][0], v1 = acc[ai][bj][m][1];
                float v[8];
#pragma unroll
                for (int i = 0; i < 4; ++i) { v[i] = v0[i] * g[i]; v[4 + i] = v1[i] * g[4 + i]; }
                if (b > 0) { float mm[8]; unpack8(mq[s][bj], mm);
#pragma unroll
                    for (int i = 0; i < 8; ++i) v[i] += mm[i]; }
                wq[bj] = pack8(v);
                if (b < 2) mp[(size_t)(grp * 2 + bj) * 512] = wq[bj];
            }
            if (b == 2) store_pair(MRGB, 2048, row - fr, col0, fr, wq[0], wq[1]);
        }
#undef BR_LOAD
    }
};
struct TrItem { const float* W; bf16* WT; int Nsrc, K, k0, src, dstrow; };
DI void tr_load(const TrItem& t, LAS float* scr, int lane) {
#pragma unroll
    for (int i = 0; i < 8; ++i) {
        const int kk = 8 * i + (lane >> 3), c4 = (lane & 7) * 4;
        f32x4 v = (f32x4){0.f, 0.f, 0.f, 0.f};
        if (t.src >= 0) v = *(const f32x4*)(t.W + (size_t)(t.k0 + kk) * t.Nsrc + t.src + c4);
        scr[kk * 33 + c4] = v[0]; scr[kk * 33 + c4 + 1] = v[1]; scr[kk * 33 + c4 + 2] = v[2]; scr[kk * 33 + c4 + 3] = v[3];
    }
}
DI void tr_store(const TrItem& t, const LAS float* scr, int lane) {
    const int c = lane & 7;
#pragma unroll
    for (int j = 0; j < 4; ++j) {
        const int n = (lane >> 3) + 8 * j; const LAS float* s = scr + (8 * c) * 33 + n;
        v4u o; o.x = pk2(s[0 * 33], s[1 * 33]); o.y = pk2(s[2 * 33], s[3 * 33]); o.z = pk2(s[4 * 33], s[5 * 33]); o.w = pk2(s[6 * 33], s[7 * 33]);
        *(v4u*)(t.WT + (size_t)(t.dstrow + n) * t.K + t.k0 + 8 * c) = o;
    }
}
DI TrItem tr_decode(KP P, int l, int it) {
    constexpr int I_GU = 32 * 352, I_DN = 88 * 64, I_IN = 32 * 520, I_BR = 16 * 64;
    bf16* WT = (bf16*)(PWS + WS_WT);
    TrItem t; int r = it;
    if (r < 2 * I_GU) {
        const int f = r / I_GU; r -= f * I_GU;
        const int kb = r / 352, nb = r % 352, j = nb >> 3, q = nb & 7, hh = q >> 2, qq = q & 3;
        t.W = (f ? PIN(15) : PIN(13)) + (size_t)l * DM * 2 * DFF; t.WT = WT + (f ? WT_GU2 : WT_GU1); t.Nsrc = 2 * DFF; t.K = DM; t.k0 = 64 * kb; t.src = hh * DFF + 128 * j + 32 * qq; t.dstrow = 32 * nb;
        return t;
    }
    r -= 2 * I_GU;
    if (r < 2 * I_DN) {
        const int f = r / I_DN; r -= f * I_DN;
        const int kb = r / 64, nb = r % 64;
        t.W = (f ? PIN(16) : PIN(14)) + (size_t)l * DFF * DM; t.WT = WT + (f ? WT_DN2 : WT_DN1); t.Nsrc = DM; t.K = DFF; t.k0 = 64 * kb; t.src = 32 * nb; t.dstrow = 32 * nb;
        return t;
    }
    r -= 2 * I_DN;
    if (r < I_IN) {
        const int kb = r / 520, nb = r % 520, n0 = 32 * nb;
        t.W = PIN(17) + (size_t)l * DM * NINR; t.WT = WT + WT_IN; t.Nsrc = NINR; t.K = DM; t.k0 = 64 * kb; t.dstrow = n0;
        t.src = n0 < 7168 ? n0 : (n0 < 16384 ? n0 + 32 : (n0 < 16416 ? 7168 + (n0 - 16384) : -1));
        return t;
    }
    r -= I_IN;
    if (r < 3 * I_BR) {
        const int b = r / I_BR; r -= b * I_BR;
        const int kb = r / 64, nb = r % 64;
        t.W = (b == 0 ? PIN(25) : (b == 1 ? PIN(26) : PIN(27))) + (size_t)l * 1024 * DM; t.WT = WT + WT_BR + (size_t)b * DM * 1024; t.Nsrc = DM; t.K = 1024; t.k0 = 64 * kb; t.src = 32 * nb; t.dstrow = 32 * nb;
        return t;
    }
    r -= 3 * I_BR;
    { const int kb = r / 64, nb = r % 64;
      t.W = PIN(28) + (size_t)l * DM * DM; t.WT = WT + WT_OUT; t.Nsrc = DM; t.K = DM; t.k0 = 64 * kb; t.src = 32 * nb; t.dstrow = 32 * nb; }
    return t;
}
DI void step_weights(KP P, const Ctx& C, int l) {
    LAS float* scr = (LAS float*)(C.L + LDS_SCR + C.wave * 17408);
    constexpr int NITEMS = 2 * 32 * 352 + 2 * 88 * 64 + 32 * 520 + 3 * 16 * 64 + 32 * 64;
    for (int it = 2 * C.gw; it < NITEMS; it += 2 * C.ngw) {
        const TrItem t0 = tr_decode(P, l, it); const bool two = it + 1 < NITEMS; const TrItem t1 = tr_decode(P, l, two ? it + 1 : it);
        tr_load(t0, scr, C.lane); if (two) tr_load(t1, scr + 64 * 33 + 64, C.lane);
        LDS_WAIT(); asm volatile("" ::: "memory");
        tr_store(t0, scr, C.lane); if (two) tr_store(t1, scr + 64 * 33 + 64, C.lane);
        LDS_WAIT(); asm volatile("" ::: "memory");
    }
}
DI void step_modpartial(KP P, const Ctx& C) {
    LAS float* sc = (LAS float*)(C.L + LDS_SCR + 140 * 1024);
    float* MODP = (float*)(PWS + WS_MODP);
    for (int task = C.bid; task < 2 * 8 * 36; task += C.G) {
        const int cc = task % 36, p = (task / 36) & 7, l = task / 288;
        __syncthreads();
        for (int e = C.tid; e < 9 * 256; e += NTHR) {
            const int s = e >> 8, k = 256 * p + (e & 255);
            const float cv = s == 0 ? PIN(8)[k] : PIN(7)[(size_t)(s - 1) * DM + k];
            sc[e] = siluf(cv);
        }
        __syncthreads();
        const int j = cc * 512 + C.tid;
        const float* W = PIN(9) + ((size_t)l * DM + 256 * p) * NMODV + j;
        float acc[9];
#pragma unroll
        for (int s = 0; s < 9; ++s) acc[s] = 0.f;
#pragma unroll 8
        for (int k = 0; k < 256; ++k) {
            const float w = W[(size_t)k * NMODV];
#pragma unroll
            for (int s = 0; s < 9; ++s) acc[s] += sc[s * 256 + k] * w;
        }
#pragma unroll
        for (int s = 0; s < 9; ++s) MODP[(((size_t)p * 2 + l) * 9 + s) * NMODV + j] = acc[s];
    }
}
DI void step_modreduce(KP P, const Ctx& C) {
    const float* MODP = (const float*)(PWS + WS_MODP); float* MOD = (float*)(PWS + WS_MOD);
    for (int e = C.bid * NTHR + C.tid; e < 2 * 9 * NMODV; e += C.G * NTHR) {
        const int l = e / (9 * NMODV), j = e % NMODV;
        float a = PIN(10)[(size_t)l * NMODV + j];
#pragma unroll
        for (int p = 0; p < 8; ++p) a += MODP[(size_t)p * 2 * 9 * NMODV + e];
        MOD[e] = a;
    }
}
DI void step_caches(KP P, const Ctx& C) {
    constexpr size_t N8 = 4194304 / 8;
    for (size_t i = (size_t)C.bid * NTHR + C.tid; i < 4 * N8; i += (size_t)C.G * NTHR) {
        const int w = (int)(i / N8); const size_t j = i % N8;
        const float* src = (w == 0 ? PIN(2) : (w == 1 ? PIN(3) : (w == 2 ? PIN(5) : PIN(6)))) + j * 8;
        bf16* dst = (bf16*)(PWS + (w == 0 ? WS_CKNA : (w == 1 ? WS_CVNA : (w == 2 ? WS_CKD : WS_CVD)))) + j * 8;
        const f32x4 a = *(const f32x4*)src, b = *(const f32x4*)(src + 4);
        v4u o; o.x = pk2(a[0], a[1]); o.y = pk2(a[2], a[3]); o.z = pk2(b[0], b[1]); o.w = pk2(b[2], b[3]);
        *(v4u*)dst = o;
    }
    if (C.bid == 0) {
        float* R = (float*)(PWS + WS_ROPE);
        for (int e = C.tid; e < 64 * 32; e += NTHR) {
            const int pos = e >> 5, i = e & 31;
            const float inv = powf(10000.0f, -(float)i / 32.0f), ang = (float)pos * inv;
            R[2 * e] = cosf(ang); R[2 * e + 1] = sinf(ang);
        }
    }
}
template <int XSRC  , int XF32  >
DI void step_rows(KP P, const Ctx& C, int l, int post, float coef, int lp, int pre) {
    float* X = POUT; bf16* XB = (bf16*)(PWS + WS_XB); const bf16* Y = (const bf16*)(PWS + WS_Y); bf16* H = (bf16*)(PWS + WS_H);
    const float* MOD = (const float*)(PWS + WS_MOD);
    const int rpb = (MTOT + C.G - 1) / C.G, r0 = C.bid * rpb, r1 = min(r0 + rpb, MTOT);
    LAS float* vw = (LAS float*)(C.L + LDS_SCR);
    const int setA = r0 < NCTX ? 0 : 1 + ((r0 - NCTX) >> 12);
    __syncthreads();
    if (r0 < r1) {
        const int setB = (r1 - 1) < NCTX ? 0 : 1 + ((r1 - 1 - NCTX) >> 12);
        for (int e = C.tid; e < 8 * 512; e += NTHR) {
            const int v = e >> 9, c4 = (e & 511) * 4;
            const float* src;
            if (v == 0) src = PIN(12) + (size_t)(l * 3 + (post < 0 ? 0 : post)) * DM;
            else if (v == 1) src = PIN(11) + (size_t)(lp * 3 + (pre < 0 ? 0 : pre)) * DM;
            else { const int s = (v - 2) / 3, k = (v - 2) % 3, st = s ? setB : setA;
                   src = k == 0 ? MOD + ((size_t)(l * 9 + st) * 9 + 3 * (post < 0 ? 0 : post) + 2) * DM : MOD + ((size_t)(lp * 9 + st) * 9 + 3 * (pre < 0 ? 0 : pre) + (k - 1)) * DM; }
            *(LAS f32x4*)(vw + v * DM + c4) = *(const f32x4*)(src + c4);
        }
    }
    __syncthreads();
    f32x4 xn[8]; v2u xbn[8]; v2u yn[8];
#define ROWS_LOAD(mm) do { const int m_ = (mm); \
        if (XSRC == 1) { const float* src = m_ < NCTX ? PIN(0) + (size_t)m_ * DM : PIN(1) + (size_t)(m_ - NCTX) * DM; \
            _Pragma("unroll") for (int j = 0; j < 8; ++j) xn[j] = *(const f32x4*)(src + 4 * C.lane + 256 * j); } \
        else { const bf16* xr = XB + (size_t)m_ * DM; \
            _Pragma("unroll") for (int j = 0; j < 8; ++j) xbn[j] = *(const v2u*)(xr + 4 * C.lane + 256 * j); } \
        if (post >= 0) { const bf16* yr = Y + (size_t)m_ * DM; \
            _Pragma("unroll") for (int j = 0; j < 8; ++j) yn[j] = *(const v2u*)(yr + 4 * C.lane + 256 * j); } } while (0)
    if (r0 + C.wave < r1) ROWS_LOAD(r0 + C.wave);
    for (int m = r0 + C.wave; m < r1; m += NWAVES) {
        const int set = m < NCTX ? 0 : 1 + ((m - NCTX) >> 12);
        const LAS float* vs = vw + 2 * DM + (set == setA ? 0 : 3 * DM);
        f32x4 xv[8]; v2u yc[8];
#pragma unroll
        for (int j = 0; j < 8; ++j) {
            if (XSRC == 1) xv[j] = xn[j];
            else { const v2u xw = xbn[j]; xv[j][0] = bf2f(xw.x & 0xffffu); xv[j][1] = bf2f(xw.x >> 16); xv[j][2] = bf2f(xw.y & 0xffffu); xv[j][3] = bf2f(xw.y >> 16); }
            yc[j] = yn[j]; }
        if (m + NWAVES < r1) ROWS_LOAD(m + NWAVES);
        if (post >= 0) {
            f32x4 yv[8]; float ss = 0.f;
#pragma unroll
            for (int j = 0; j < 8; ++j) { const v2u yw = yc[j];
                yv[j][0] = bf2f(yw.x & 0xffffu); yv[j][1] = bf2f(yw.x >> 16); yv[j][2] = bf2f(yw.y & 0xffffu); yv[j][3] = bf2f(yw.y >> 16);
                ss += (yv[j][0] * yv[j][0] + yv[j][1] * yv[j][1]) + (yv[j][2] * yv[j][2] + yv[j][3] * yv[j][3]); }
            const float r = rsqrtf(wave_sum(ss) * (1.f / DM) + EPSF) * coef;
#pragma unroll
            for (int j = 0; j < 8; ++j) {
                const f32x4 g = *(const LAS f32x4*)(vs + 4 * C.lane + 256 * j), w = *(const LAS f32x4*)(vw + 4 * C.lane + 256 * j);
                xv[j] = xv[j] + g * (yv[j] * r * w);
            }
            if (XF32) {
                float* xo = X + (size_t)m * DM;
#pragma unroll
                for (int j = 0; j < 8; ++j) *(f32x4*)(xo + 4 * C.lane + 256 * j) = xv[j];
            } else {
                bf16* xo = XB + (size_t)m * DM;
#pragma unroll
                for (int j = 0; j < 8; ++j) { v2u o; o.x = pk2(xv[j][0], xv[j][1]); o.y = pk2(xv[j][2], xv[j][3]); *(v2u*)(xo + 4 * C.lane + 256 * j) = o; }
            }
        }
        if (pre >= 0) {
            float ss = 0.f;
#pragma unroll
            for (int j = 0; j < 8; ++j) ss += (xv[j][0] * xv[j][0] + xv[j][1] * xv[j][1]) + (xv[j][2] * xv[j][2] + xv[j][3] * xv[j][3]);
            const float r = rsqrtf(wave_sum(ss) * (1.f / DM) + EPSF);
            bf16* ho = H + (size_t)m * DM;
#pragma unroll
            for (int j = 0; j < 8; ++j) {
                const f32x4 sh = *(const LAS f32x4*)(vs + DM + 4 * C.lane + 256 * j), sc = *(const LAS f32x4*)(vs + 2 * DM + 4 * C.lane + 256 * j), w = *(const LAS f32x4*)(vw + DM + 4 * C.lane + 256 * j);
                const f32x4 h = (xv[j] * r * w) * (sc + 1.f) + sh;
                v2u o; o.x = pk2(h[0], h[1]); o.y = pk2(h[2], h[3]);
                *(v2u*)(ho + 4 * C.lane + 256 * j) = o;
            }
        }
    }
#undef ROWS_LOAD
}
DI void step_prep(KP P, const Ctx& C, int l, int g) {
    const bf16* SEG = (const bf16*)(PWS + WS_SEG);
    const int T = g == 0 ? CT : LT;
    LAS float* cw = (LAS float*)(C.L + LDS_SCR);
    __syncthreads();
    for (int e = C.tid; e < 9216; e += NTHR) cw[e] = PIN(19)[(size_t)l * 9216 + e];
    __syncthreads();
    float* BL = (float*)(PWS + WS_BL);
    {
        typedef float f32x4t __attribute__((ext_vector_type(4)));
        const int r16 = C.lane & 15, quad = C.lane >> 4;
        LAS f32x4t* part = (LAS f32x4t*)(C.L + LDS_SCR + 40960);
        const bf16* Hg = (const bf16*)(PWS + WS_H) + (size_t)g * MG * DM; const bf16* Wab = (const bf16*)(PWS + WS_WT) + WT_IN + (size_t)16384 * DM;
        for (int task = C.bid; task < MG / 16; task += C.G) {
            const bf16* ap = Hg + (size_t)(16 * task + r16) * DM + 256 * C.wave + 8 * quad; const bf16* b0 = Wab + (size_t)r16 * DM + 256 * C.wave + 8 * quad; const bf16* b1 = b0 + (size_t)16 * DM;
            bf16x8 av[8], bv0[8], bv1[8];
#pragma unroll
            for (int kk = 0; kk < 8; ++kk) { av[kk] = *(const bf16x8*)(ap + 32 * kk); bv0[kk] = *(const bf16x8*)(b0 + 32 * kk); bv1[kk] = *(const bf16x8*)(b1 + 32 * kk); }
            f32x4t a0 = (f32x4t){0.f, 0.f, 0.f, 0.f}, a1 = a0;
#pragma unroll
            for (int kk = 0; kk < 8; ++kk) { a0 = __builtin_amdgcn_mfma_f32_16x16x32_bf16(av[kk], bv0[kk], a0, 0, 0, 0); a1 = __builtin_amdgcn_mfma_f32_16x16x32_bf16(av[kk], bv1[kk], a1, 0, 0, 0); }
            __syncthreads();
            part[(C.wave * 2 + 0) * 64 + C.lane] = a0; part[(C.wave * 2 + 1) * 64 + C.lane] = a1;
            __syncthreads();
            if (C.wave < 2) {
                f32x4t s = part[C.wave * 64 + C.lane];
#pragma unroll
                for (int ww = 1; ww < 8; ++ww) s = s + part[(ww * 2 + C.wave) * 64 + C.lane];
                const float alog = PIN(20)[l * 16 + r16], dtb = PIN(21)[l * 16 + r16];
#pragma unroll
                for (int j = 0; j < 4; ++j) {
                    const int row = 16 * task + 4 * quad + j;
                    if (C.wave == 0) BL[(size_t)row * 32 + r16] = sigmf(s[j]);
                    else { const float xa = s[j] + dtb, sp = fmaxf(xa, 0.f) + log1pf(__expf(-fabsf(xa))); BL[(size_t)row * 32 + 16 + r16] = -__expf(alog) * sp; }
                }
            }
        }
    }
    for (int r0 = 4 * C.gw; r0 < MG; r0 += 4 * C.ngw) {
        const int t0 = r0 & (T - 1);
        const bool hp = t0 > 0, hn = (t0 + 3) < T - 1;
        const float fp = hp ? 1.f : 0.f, fn = hn ? 1.f : 0.f;
        const int rp = hp ? r0 - 1 : r0, rn = hn ? r0 + 4 : r0 + 3;
        v4u rawA[6][2], rawB[6][2];
#define PREP_LOADSEG(RAW, w_) do { const bf16* sb_ = SEG + (size_t)(3 + (w_)) * SEGSZ + 8 * C.lane; \
            _Pragma("unroll") for (int k = 0; k < 6; ++k) { const int rk = k == 0 ? rp : (k == 5 ? rn : r0 + k - 1); \
                _Pragma("unroll") for (int hf = 0; hf < 2; ++hf) RAW[k][hf] = *(const v4u*)(sb_ + (size_t)rk * 1024 + 512 * hf); } } while (0)
#define PREP_COMPUTE(RAW, w_) do { constexpr int w = (w_); bf16* dstb = (bf16*)(PWS + (w == 0 ? WS_QN : (w == 1 ? WS_KN : WS_VN))) + 8 * C.lane; \
            _Pragma("unroll") for (int r = 0; r < 4; ++r) { const float mp = r == 0 ? fp : 1.f, mn = r == 3 ? fn : 1.f; \
                _Pragma("unroll") for (int hf = 0; hf < 2; ++hf) { \
                    float xp[8], xc[8], xn[8], y[8]; unpack8(RAW[r][hf], xp); unpack8(RAW[r + 1][hf], xc); unpack8(RAW[r + 2][hf], xn); \
                    const int ch = w * 1024 + 512 * hf + 8 * C.lane; float c0[8], c1[8], c2[8]; \
                    _Pragma("unroll") for (int q = 0; q < 2; ++q) { const f32x4 a0 = *(const LAS f32x4*)(cw + ch + 4 * q), a1 = *(const LAS f32x4*)(cw + 3072 + ch + 4 * q), a2 = *(const LAS f32x4*)(cw + 6144 + ch + 4 * q); \
                        _Pragma("unroll") for (int i = 0; i < 4; ++i) { c0[4 * q + i] = a0[i]; c1[4 * q + i] = a1[i]; c2[4 * q + i] = a2[i]; } } \
                    float ss = 0.f; \
                    _Pragma("unroll") for (int i = 0; i < 8; ++i) { const float cv = (mp * xp[i]) * c0[i] + xc[i] * c1[i] + (mn * xn[i]) * c2[i]; y[i] = siluf(cv); ss += y[i] * y[i]; } \
                    if (w < 2) { ss += __shfl_xor(ss, 1); ss += __shfl_xor(ss, 2); ss += __shfl_xor(ss, 4); ss += __shfl_xor(ss, 8); \
                        const float rr = rsqrtf(ss + EPSF) * (w == 0 ? QSCALE : 1.f); \
                        _Pragma("unroll") for (int i = 0; i < 8; ++i) y[i] *= rr; } \
                    *(v4u*)(dstb + (size_t)(r0 + r) * 1024 + 512 * hf) = pack8(y); } } } while (0)
        PREP_LOADSEG(rawA, 0); PREP_LOADSEG(rawB, 1); __builtin_amdgcn_sched_barrier(0);
        PREP_COMPUTE(rawA, 0); __builtin_amdgcn_sched_barrier(0);
        PREP_LOADSEG(rawA, 2); __builtin_amdgcn_sched_barrier(0);
        PREP_COMPUTE(rawB, 1); __builtin_amdgcn_sched_barrier(0);
        PREP_COMPUTE(rawA, 2); __builtin_amdgcn_sched_barrier(0);
        v4u own[4][2][2];
        if (g > 0) {
#pragma unroll
            for (int r = 0; r < 4; ++r)
#pragma unroll
                for (int w = 0; w < 2; ++w)
#pragma unroll
                    for (int hf = 0; hf < 2; ++hf) own[r][w][hf] = *(const v4u*)((const bf16*)(PWS + WS_SEG) + (size_t)(7 + w) * SEGSZ + (size_t)(r0 + r) * 1024 + 512 * hf + 8 * C.lane);
        }
#undef PREP_LOADSEG
#undef PREP_COMPUTE
        if (g > 0) {
            const float* R = (const float*)(PWS + WS_ROPE);
            const int a = (C.lane >> 3) & 1, i0 = 8 * (C.lane & 3);
            const float sgn = ((C.lane >> 2) & 1) ? 1.f : -1.f;
#pragma unroll
            for (int r = 0; r < 4; ++r) {
                const int t = t0 + r, pos = a == 0 ? (t >> 6) : (t & 63);
                float cs[8], sn[8];
#pragma unroll
                for (int k = 0; k < 4; ++k) { const f32x4 v = *(const f32x4*)(R + (size_t)(pos * 32 + i0 + 2 * k) * 2); cs[2 * k] = v[0]; sn[2 * k] = v[1]; cs[2 * k + 1] = v[2]; sn[2 * k + 1] = v[3]; }
#pragma unroll
                for (int w = 0; w < 2; ++w) {
#pragma unroll
                    for (int hf = 0; hf < 2; ++hf) {
                        const size_t off = (size_t)(r0 + r) * 1024 + 512 * hf + 8 * C.lane;
                        const v4u ow = own[r][w][hf];
                        v4u oth; oth.x = __shfl_xor(ow.x, 4); oth.y = __shfl_xor(ow.y, 4); oth.z = __shfl_xor(ow.z, 4); oth.w = __shfl_xor(ow.w, 4);
                        float xo[8], xt[8], y[8]; unpack8(ow, xo); unpack8(oth, xt);
#pragma unroll
                        for (int i = 0; i < 8; ++i) y[i] = xo[i] * cs[i] + sgn * (xt[i] * sn[i]);
                        *(v4u*)((bf16*)(PWS + (w == 0 ? WS_DQR : WS_DKR)) + off) = pack8(y);
                    }
                }
            }
        }
    }
}
DI void step_post(KP P, const Ctx& C, int l) {
    const float* OGF = (const float*)(PWS + WS_OGF); const float* OGB = (const float*)(PWS + WS_OGB);
    const bf16* GZ = (const bf16*)(PWS + WS_SEG) + (size_t)6 * SEGSZ; const bf16* DOb = (const bf16*)(PWS + WS_DO);
    bf16* OG = (bf16*)(PWS + WS_OG); bf16* OD = (bf16*)(PWS + WS_OD);
    float lam, lam_init;
    {
        const float* L4 = PIN(23) + (size_t)l * 512;
        const float a = L4[C.lane] * L4[128 + C.lane] + L4[64 + C.lane] * L4[128 + 64 + C.lane];
        const float b = L4[256 + C.lane] * L4[384 + C.lane] + L4[256 + 64 + C.lane] * L4[384 + 64 + C.lane];
        lam_init = 0.8f - 0.6f * expf(-0.3f * (float)l);
        lam = expf(wave_sum(a)) - expf(wave_sum(b)) + lam_init;
    }
    const int c4 = 4 * C.lane;
    float gw_[4], dw_[4];
#pragma unroll
    for (int i = 0; i < 4; ++i) { gw_[i] = PIN(22)[(size_t)l * 128 + ((c4 + i) & 127)]; dw_[i] = PIN(24)[(size_t)l * 256 + c4 + i] * (1.f - lam_init); }
    f32x4 ofn[4], obn[4]; v2u gzn[4], d0n[4], d1n[4];
#define POST_LOAD(rr) do { const size_t r_ = (size_t)(rr); \
        _Pragma("unroll") for (int q = 0; q < 4; ++q) { \
            ofn[q] = *(const f32x4*)(OGF + r_ * 1024 + 256 * q + c4); obn[q] = *(const f32x4*)(OGB + r_ * 1024 + 256 * q + c4); \
            gzn[q] = *(const v2u*)(GZ + r_ * 1024 + 256 * q + c4); \
            d0n[q] = *(const v2u*)(DOb + r_ * 2048 + 512 * q + c4); d1n[q] = *(const v2u*)(DOb + r_ * 2048 + 512 * q + 256 + c4); } } while (0)
    if (C.gw < MG) POST_LOAD(C.gw);
    for (int row = C.gw; row < MG; row += C.ngw) {
        f32x4 of[4], ob[4]; v2u gz[4], d0[4], d1[4];
#pragma unroll
        for (int q = 0; q < 4; ++q) { of[q] = ofn[q]; ob[q] = obn[q]; gz[q] = gzn[q]; d0[q] = d0n[q]; d1[q] = d1n[q]; }
        POST_LOAD(row + C.ngw < MG ? row + C.ngw : row);
#pragma unroll
        for (int q = 0; q < 4; ++q) {
            const f32x4 o = of[q] + ob[q];
            float ss = (o[0] * o[0] + o[1] * o[1]) + (o[2] * o[2] + o[3] * o[3]);
            ss += __shfl_xor(ss, 1); ss += __shfl_xor(ss, 2); ss += __shfl_xor(ss, 4); ss += __shfl_xor(ss, 8); ss += __shfl_xor(ss, 16);
            const float r = rsqrtf(ss * (1.f / 128.f) + EPSF);
            const v2u zw = gz[q];
            const float z0 = bf2f(zw.x & 0xffffu), z1 = bf2f(zw.x >> 16), z2 = bf2f(zw.y & 0xffffu), z3 = bf2f(zw.y >> 16);
            v2u w; w.x = pk2(o[0] * r * gw_[0] * siluf(z0), o[1] * r * gw_[1] * siluf(z1)); w.y = pk2(o[2] * r * gw_[2] * siluf(z2), o[3] * r * gw_[3] * siluf(z3));
            *(v2u*)(OG + (size_t)row * 1024 + 256 * q + c4) = w;
        }
#pragma unroll
        for (int q = 0; q < 4; ++q) {
            const v2u aw = d0[q], bw = d1[q];
            float o[4];
            o[0] = bf2f(aw.x & 0xffffu) - lam * bf2f(bw.x & 0xffffu); o[1] = bf2f(aw.x >> 16) - lam * bf2f(bw.x >> 16);
            o[2] = bf2f(aw.y & 0xffffu) - lam * bf2f(bw.y & 0xffffu); o[3] = bf2f(aw.y >> 16) - lam * bf2f(bw.y >> 16);
            const float ss = wave_sum((o[0] * o[0] + o[1] * o[1]) + (o[2] * o[2] + o[3] * o[3]));
            const float r = rsqrtf(ss * (1.f / 256.f) + EPSF);
            v2u w; w.x = pk2(o[0] * r * dw_[0], o[1] * r * dw_[1]); w.y = pk2(o[2] * r * dw_[2], o[3] * r * dw_[3]);
            *(v2u*)(OD + (size_t)row * 1024 + 256 * q + c4) = w;
        }
    }
#undef POST_LOAD
}
namespace at2 {
using f32x16 = __attribute__((ext_vector_type(16))) float;
using s16x4  = __attribute__((ext_vector_type(4))) short;
using u32x4  = __attribute__((ext_vector_type(4))) unsigned;
constexpr int D = 128, NW = 8, QBLK = 32, KVBLK = 64, LDX = 1024;
constexpr float SCALE = 0.088388347648318440f, THR = 8.f, INV_SCALE = 11.313708498984761f;

constexpr size_t SHM_V = KVBLK * D * 2, SHM_K = KVBLK * D * 2, SHM_ATTN = 2 * SHM_V + 2 * SHM_K + NW * 64 * 4;
#define KSWZ(row, colB) ((row) * 256 + ((colB) ^ (((row) & 7) << 4)))
#define SBAR() __builtin_amdgcn_sched_barrier(0)
DI int crow(int r, int hi) { return (r & 3) + 8 * (r >> 2) + 4 * hi; }
DI unsigned cvtpk(float lo, float hi) { unsigned r; asm volatile("v_cvt_pk_bf16_f32 %0, %1, %2" : "=v"(r) : "v"(lo), "v"(hi)); return r; }

struct NaMask { int on, r0, kr_lo; const LAS float* bias; };

DI void partialSM(f32x16& p0, f32x16& p1, float& m_reg, float& mn, float& alpha) {
  constexpr float C = SCALE * 1.4426950408889634f;
  float pmax = p0[0];
#pragma unroll
  for (int r = 1; r < 16; ++r) pmax = fmaxf(pmax, p0[r]);
#pragma unroll
  for (int r = 0; r < 16; ++r) pmax = fmaxf(pmax, p1[r]);
  { auto rr = __builtin_amdgcn_permlane32_swap(__float_as_uint(pmax), __float_as_uint(pmax), false, false);
    pmax = fmaxf(__uint_as_float(rr[0]), __uint_as_float(rr[1])); }
  if (__builtin_expect(__all(pmax - m_reg <= THR / SCALE), 1)) { mn = m_reg; alpha = 1.f; }
  else { mn = fmaxf(m_reg, pmax); alpha = __builtin_amdgcn_exp2f((m_reg - mn) * C); m_reg = mn; }
  float mnC = -mn * C;
#pragma unroll
  for (int r = 0; r < 16; ++r) p0[r] = fmaf(p0[r], C, mnC);
#pragma unroll
  for (int r = 0; r < 16; ++r) p1[r] = fmaf(p1[r], C, mnC);
#pragma unroll
  for (int r = 0; r < 16; ++r) p0[r] = __builtin_amdgcn_exp2f(p0[r]);
}
DI void finishSM(f32x16& p0, f32x16& p1, float alpha, float& l_reg, bf16x8& pa0, bf16x8& pa1, bf16x8& pa2, bf16x8& pa3) {
#pragma unroll
  for (int r = 0; r < 16; ++r) p1[r] = __builtin_amdgcn_exp2f(p1[r]);
  float ps = 0;
#pragma unroll
  for (int r = 0; r < 16; ++r) ps += p0[r];
#pragma unroll
  for (int r = 0; r < 16; ++r) ps += p1[r];
  { auto rr = __builtin_amdgcn_permlane32_swap(__float_as_uint(ps), __float_as_uint(ps), false, false);
    ps = __uint_as_float(rr[0]) + __uint_as_float(rr[1]); }
  l_reg = l_reg * alpha + ps;
#define PK4(P, BASE, OUT) do { unsigned a0 = cvtpk(P[BASE + 0], P[BASE + 1]), a1 = cvtpk(P[BASE + 2], P[BASE + 3]);   \
    unsigned b0 = cvtpk(P[BASE + 4], P[BASE + 5]), b1 = cvtpk(P[BASE + 6], P[BASE + 7]);                              \
    auto r0 = __builtin_amdgcn_permlane32_swap(a0, b0, false, false); auto r1 = __builtin_amdgcn_permlane32_swap(a1, b1, false, false); \
    u32x4 w = {r0[0], r1[0], r0[1], r1[1]}; OUT = *reinterpret_cast<bf16x8*>(&w); } while (0)
  PK4(p0, 0, pa0); PK4(p0, 8, pa1); PK4(p1, 0, pa2); PK4(p1, 8, pa3);
#undef PK4
}
template <bool QLDS> DI void qkt(f32x16& p0, f32x16& p1, const bf16* Ks, const bf16x8* qr, const char* qlds, int r32, int hi) {
  p0 = f32x16{}; p1 = f32x16{};
#pragma unroll
  for (int d0 = 0; d0 < 8; ++d0) { int cb = (d0 * 16 + hi * 8) * 2;
    bf16x8 qv; if constexpr (QLDS) qv = *reinterpret_cast<const bf16x8*>(qlds + d0 * 1024); else qv = qr[d0];
    bf16x8 b0 = *reinterpret_cast<const bf16x8*>((const char*)Ks + KSWZ(r32, cb));
    bf16x8 b1 = *reinterpret_cast<const bf16x8*>((const char*)Ks + KSWZ(32 + r32, cb));
    p0 = __builtin_amdgcn_mfma_f32_32x32x16_bf16(b0, qv, p0, 0, 0, 0);
    p1 = __builtin_amdgcn_mfma_f32_32x32x16_bf16(b1, qv, p1, 0, 0, 0); }
}
DI void na_mask(f32x16& p0, f32x16& p1, int jt, int wid, int r32, int hi, const NaMask& mk) {
  if (jt < 4) return;
  const int kr = mk.kr_lo + (jt - 4), r = mk.r0 + (wid >> 1), c = (wid & 1) * 32 + r32;
  const int rs = min(max(r - 4, 0), 56), cs = min(max(c - 8, 0), 48);
  const bool rv = (kr >= rs) && (kr < rs + 8);
  const int dr = rv ? (kr - r + 7) : 0;
  const LAS float* brow = mk.bias + dr * 31 + (15 - c);
#pragma unroll
  for (int i = 0; i < 16; ++i) {
    const int kc0 = crow(i, hi), kc1 = kc0 + 32;
    const bool ok0 = rv && ((unsigned)(kc0 - cs) < 16u), ok1 = rv && ((unsigned)(kc1 - cs) < 16u);
    const float b0 = brow[ok0 ? kc0 : c], b1 = brow[ok1 ? kc1 : c];
    p0[i] = ok0 ? fmaf(b0, INV_SCALE, p0[i]) : -1e30f;
    p1[i] = ok1 ? fmaf(b1, INV_SCALE, p1[i]) : -1e30f;
  }
}
DI int v_st(int k, int c) { const int kk = (k & ~0xC) | ((k & 4) << 1) | ((k & 8) >> 1); return ((kk >> 3) * 4 + (c >> 5)) * 512 + ((kk & 7) * 32 + (c & 31)) * 2; }
DI int v_rd_base(int lane) { return ((lane & 3) << 3) | (((lane >> 2) & 3) << 6) | (((lane >> 4) & 1) << 5) | (((lane >> 5) & 1) << 8); }
constexpr int v_rd_off(int d0, int ks, int half) { return d0 * 512 + ks * 4096 + half * 2048; }
template <int OFF> DI s16x4 tr_read(int vb) {
  s16x4 r; asm volatile("ds_read_b64_tr_b16 %0, %1 offset:%2" : "=&v"(r) : "v"(vb), "i"(OFF) : "memory"); return r;
}
template <int D0> DI void pv_one(f32x16& od, int vb, bf16x8 pa0, bf16x8 pa1, bf16x8 pa2, bf16x8 pa3) {
  const s16x4 l0 = tr_read<v_rd_off(D0, 0, 0)>(vb), h0 = tr_read<v_rd_off(D0, 0, 1)>(vb), l1 = tr_read<v_rd_off(D0, 1, 0)>(vb), h1 = tr_read<v_rd_off(D0, 1, 1)>(vb);
  const s16x4 l2 = tr_read<v_rd_off(D0, 2, 0)>(vb), h2 = tr_read<v_rd_off(D0, 2, 1)>(vb), l3 = tr_read<v_rd_off(D0, 3, 0)>(vb), h3 = tr_read<v_rd_off(D0, 3, 1)>(vb);
  asm volatile("s_waitcnt lgkmcnt(0)" ::: "memory"); SBAR();
#define PK(L, H) (bf16x8){L[0], L[1], L[2], L[3], H[0], H[1], H[2], H[3]}
  od = __builtin_amdgcn_mfma_f32_32x32x16_bf16(pa0, PK(l0, h0), od, 0, 0, 0);
  od = __builtin_amdgcn_mfma_f32_32x32x16_bf16(pa1, PK(l1, h1), od, 0, 0, 0);
  od = __builtin_amdgcn_mfma_f32_32x32x16_bf16(pa2, PK(l2, h2), od, 0, 0, 0);
  od = __builtin_amdgcn_mfma_f32_32x32x16_bf16(pa3, PK(l3, h3), od, 0, 0, 0);
#undef PK
}
DI void pv_d0(f32x16* o, int vb, bf16x8 pa0, bf16x8 pa1, bf16x8 pa2, bf16x8 pa3) {
  pv_one<0>(o[0], vb, pa0, pa1, pa2, pa3); pv_one<1>(o[1], vb, pa0, pa1, pa2, pa3); pv_one<2>(o[2], vb, pa0, pa1, pa2, pa3); pv_one<3>(o[3], vb, pa0, pa1, pa2, pa3);
}

template <bool MASKED, int SDEPTH> DI void attn_body(const bf16* __restrict__ Qb, const bf16* __restrict__ K1, const bf16* __restrict__ V1, int n1,
                  const bf16* __restrict__ K2, const bf16* __restrict__ V2, int n2, bf16* __restrict__ Ob, int ldo, char* lds, const NaMask mk) {
  int tid_l = threadIdx.x; asm volatile("" : "+v"(tid_l));
  const int tid = tid_l, wid = tid >> 6, lane = tid & 63, r32 = lane & 31, hi = lane >> 5;
  bf16* V_lds = (bf16*)lds; bf16* K_lds = (bf16*)(lds + 2 * SHM_V);
  float* ws = (float*)(lds + 2 * SHM_V + 2 * SHM_K) + wid * 64; float* li_l = ws; float* al_l = ws + 32;
  float m_reg = -1e30f, l_reg = 0; f32x16 o[4] = {}; bf16x8 qr[8];
  const bf16* Qw = Qb + (long)(wid * QBLK + r32) * LDX + hi * 8;
  char* qlds = lds + SHM_ATTN + 2048 + wid * 8192 + lane * 16;
#pragma unroll
  for (int d0 = 0; d0 < 8; ++d0) { const bf16x8 qv = *reinterpret_cast<const bf16x8*>(Qw + d0 * 16); if constexpr (MASKED) *reinterpret_cast<bf16x8*>(qlds + d0 * 1024) = qv; else qr[d0] = qv; }
  const int sr = tid >> 4, sc = (tid & 15) * 8, vst0 = v_st(sr, sc), vst1 = v_st(32 + sr, sc);
  const int vb0 = (int)(uintptr_t)V_lds + v_rd_base(lane);
  const unsigned toff = (unsigned)(sr * LDX + sc) * 2u;
  struct { bf16x8 vs0, vs1, ks0, ks1; } sr_[SDEPTH];
#define SLOAD(i, k0) do { const int _k = (k0); const char* _kp = (const char*)(_k < n1 ? K1 + (long)_k * LDX : K2 + (long)(_k - n1) * LDX); const char* _vp = (const char*)(_k < n1 ? V1 + (long)_k * LDX : V2 + (long)(_k - n1) * LDX); \
    sr_[i].vs0 = *reinterpret_cast<const bf16x8*>(_vp + toff); sr_[i].vs1 = *reinterpret_cast<const bf16x8*>(_vp + 65536 + toff); \
    sr_[i].ks0 = *reinterpret_cast<const bf16x8*>(_kp + toff); sr_[i].ks1 = *reinterpret_cast<const bf16x8*>(_kp + 65536 + toff); } while (0)
#define SWRITE(b, i) do { *(bf16x8*)((char*)V_lds + (b) * SHM_V + vst0) = sr_[i].vs0;          \
    *(bf16x8*)((char*)V_lds + (b) * SHM_V + vst1) = sr_[i].vs1; int kc = sc * 2;               \
    *(bf16x8*)((char*)K_lds + (b) * SHM_K + KSWZ(sr, kc)) = sr_[i].ks0;                       \
    *(bf16x8*)((char*)K_lds + (b) * SHM_K + KSWZ(32 + sr, kc)) = sr_[i].ks1; } while (0)
#define SWAIT() do { if constexpr (SDEPTH == 2) asm volatile("s_waitcnt vmcnt(4)" ::: "memory"); else asm volatile("s_waitcnt vmcnt(0)" ::: "memory"); } while (0)
#define RESC(a) do { if (__any((a) < 1.f)) { if (hi == 0) al_l[r32] = (a); asm volatile("s_waitcnt lgkmcnt(0)" ::: "memory"); \
    _Pragma("unroll") for (int d = 0; d < 4; ++d) _Pragma("unroll") for (int r = 0; r < 16; ++r) o[d][r] *= al_l[crow(r, hi)]; } } while (0)
#define MASK(P0, P1, JT) do { if constexpr (MASKED) na_mask(P0, P1, (JT), wid, r32, hi, mk); } while (0)
  f32x16 pA0, pA1, pB0, pB1; float mnA, mnB, alA, alB; bf16x8 pa0, pa1, pa2, pa3; const int NT = (n1 + n2) / KVBLK;
  constexpr int SE = 0, SO = SDEPTH - 1;
  SLOAD(SE, 0); asm volatile("s_waitcnt vmcnt(0)" ::: "memory"); SWRITE(0, SE); __syncthreads();
  qkt<MASKED>(pA0, pA1, K_lds, qr, qlds, r32, hi); MASK(pA0, pA1, 0); partialSM(pA0, pA1, m_reg, mnA, alA);
  SLOAD(SO, KVBLK); if constexpr (SDEPTH == 2) { if (2 < NT) SLOAD(SE, 2 * KVBLK); }
  SWAIT(); SWRITE(1, SO); __syncthreads();
  for (int j = 1; j + 1 < NT; j += 2) {
    SBAR(); qkt<MASKED>(pB0, pB1, (bf16*)((char*)K_lds + SHM_K), qr, qlds, r32, hi); MASK(pB0, pB1, j);
    finishSM(pA0, pA1, alA, l_reg, pa0, pa1, pa2, pa3); SBAR();
    SLOAD(SO, (j + SDEPTH) * KVBLK); SBAR();
    pv_d0(o, vb0, pa0, pa1, pa2, pa3); partialSM(pB0, pB1, m_reg, mnB, alB);
    __syncthreads(); SWAIT(); SWRITE(0, SE);
    RESC(alB); __syncthreads();
    SBAR(); qkt<MASKED>(pA0, pA1, K_lds, qr, qlds, r32, hi); MASK(pA0, pA1, j + 1);
    finishSM(pB0, pB1, alB, l_reg, pa0, pa1, pa2, pa3); SBAR();
    if (SDEPTH == 1 || j + 3 < NT) SLOAD(SE, (j + 1 + SDEPTH) * KVBLK); SBAR();
    pv_d0(o, vb0 + (int)SHM_V, pa0, pa1, pa2, pa3); partialSM(pA0, pA1, m_reg, mnA, alA);
    __syncthreads(); SWAIT(); SWRITE(1, SO);
    RESC(alA); __syncthreads();
  }
  SBAR(); qkt<MASKED>(pB0, pB1, (bf16*)((char*)K_lds + SHM_K), qr, qlds, r32, hi); MASK(pB0, pB1, NT - 1);
  finishSM(pA0, pA1, alA, l_reg, pa0, pa1, pa2, pa3); SBAR();
  pv_d0(o, vb0, pa0, pa1, pa2, pa3); partialSM(pB0, pB1, m_reg, mnB, alB);
  __syncthreads(); RESC(alB);
  finishSM(pB0, pB1, alB, l_reg, pa0, pa1, pa2, pa3); SBAR();
  pv_d0(o, vb0 + (int)SHM_V, pa0, pa1, pa2, pa3);
  if (hi == 0) li_l[r32] = l_reg; asm volatile("s_waitcnt lgkmcnt(0)" ::: "memory");
  float rli[16];
#pragma unroll
  for (int r = 0; r < 16; ++r) rli[r] = __builtin_amdgcn_rcpf(li_l[crow(r, hi)]);
  bf16* Ow = Ob + (long)(wid * QBLK) * ldo;
#pragma unroll
  for (int r = 0; r < 16; ++r) { const int orow = crow(r, hi);
#pragma unroll
    for (int d0 = 0; d0 < 4; ++d0) Ow[(long)orow * ldo + d0 * 32 + r32] = (bf16)f2bf(o[d0][r] * rli[r]); }
#undef SLOAD
#undef SWRITE
#undef SWAIT
#undef RESC
#undef MASK
}
}
typedef float f32x4g __attribute__((ext_vector_type(4)));
DI int gdn_tok(int cg, int i, int dir, int T) {
    const int lc = T == 256 ? 2 : 6, seq = cg >> lc, c = cg & ((1 << lc) - 1);
    return dir ? seq * T + T - 1 - (64 * c + i) : cg * 64 + i;
}
#define CHK_BAR() asm volatile("s_waitcnt lgkmcnt(0)\n\ts_barrier" ::: "memory")
DI void gdn_chunk_loop(KP P, const Ctx& C, int first, int nitems, int stride, int T) {
    constexpr int XS = 272;
    LAS float* X = (LAS float*)(C.L + LDS_SCR);
    LAS float* At = X + 64 * XS;
    LAS float* kf = At + 64 * 64;
    LAS float* gm = kf + 64 * 129;
    LAS bf16* Kb = (LAS bf16*)(gm + 192);
    asm volatile("" : "+v"(X), "+v"(At), "+v"(kf), "+v"(gm), "+v"(Kb));
    const bf16* QN = (const bf16*)(PWS + WS_QN); const bf16* KN = (const bf16*)(PWS + WS_KN); const bf16* VN = (const bf16*)(PWS + WS_VN);
    const float* BL = (const float*)(PWS + WS_BL);
    const int lane = C.lane, r16 = lane & 15, quad = lane >> 4, w = C.wave, sel = w >> 2, rb = w & 3;
    bf16x8 af[4]; v4u kv[4]; float la_r = 0.f, be_r = 0.f;
#define CHK_LOAD(itx) do { const int it_ = (itx), dir_ = it_ & 1, h_ = (it_ >> 1) & 7, cg_ = it_ >> 4; \
        { const size_t ta = (size_t)gdn_tok(cg_, 16 * rb + r16, dir_, T); const bf16* ap = (sel ? QN : KN) + ta * 1024 + h_ * 128 + 8 * quad; \
          _Pragma("unroll") for (int kk = 0; kk < 4; ++kk) af[kk] = *(const bf16x8*)(ap + 32 * kk); } \
        _Pragma("unroll") for (int q = 0; q < 4; ++q) { const int e = C.tid + q * NTHR, ww = e >> 10, i = (e >> 4) & 63, c8 = (e & 15) * 8; \
          const size_t tok = (size_t)gdn_tok(cg_, i, dir_, T); kv[q] = *(const v4u*)((ww == 0 ? KN : VN) + tok * 1024 + h_ * 128 + c8); } \
        if (w == 0) { const size_t tok = (size_t)gdn_tok(cg_, lane, dir_, T); la_r = BL[tok * 32 + 16 + dir_ * 8 + h_]; be_r = BL[tok * 32 + dir_ * 8 + h_]; } } while (0)
    if (first < nitems) CHK_LOAD(first);
    for (int item = first; item < nitems; item += stride) {
        const int dir = item & 1, h = (item >> 1) & 7, cg = item >> 4;
        CHK_BAR();
        if (w == 0) {
            float la = la_r;
#pragma unroll
            for (int o = 1; o < 64; o <<= 1) { const float t = __shfl_up(la, o); if (lane >= o) la += t; }
            gm[lane] = la; gm[64 + lane] = be_r; gm[128 + lane] = __expf(la);
            ((float*)(PWS + WS_GAM))[(((size_t)dir * 128 + cg) * 8 + h) * 64 + lane] = la;
        }
#pragma unroll
        for (int q = 0; q < 2; ++q) { const int e = C.tid + q * NTHR, i = (e >> 4) & 63, c8 = (e & 15) * 8; *(LAS v4u*)(Kb + i * 136 + c8) = kv[q]; }
        CHK_BAR();
        f32x4g acc[4];
        {
            bf16x8 bfr[4][4];
#pragma unroll
            for (int cb = 0; cb < 4; ++cb)
#pragma unroll
                for (int kk = 0; kk < 4; ++kk) bfr[cb][kk] = *(const LAS bf16x8*)(Kb + (16 * cb + r16) * 136 + 32 * kk + 8 * quad);
            asm volatile("s_waitcnt lgkmcnt(0)" ::: "memory"); __builtin_amdgcn_sched_barrier(0);
#pragma unroll
            for (int cb = 0; cb < 4; ++cb) {
                acc[cb] = (f32x4g){0.f, 0.f, 0.f, 0.f};
#pragma unroll
                for (int kk = 0; kk < 4; ++kk) acc[cb] = __builtin_amdgcn_mfma_f32_16x16x32_bf16(af[kk], bfr[cb][kk], acc[cb], 0, 0, 0);
            }
            if (sel) {
                bf16* qc = (bf16*)(PWS + WS_QC) + (((size_t)dir * 128 + cg) * 8 + h) * 8192 + (size_t)(rb * 256 + lane) * 8;
#pragma unroll
                for (int kk = 0; kk < 4; ++kk) *(bf16x8*)(qc + kk * 512) = af[kk];
            }
        }
#pragma unroll
        for (int q = 0; q < 4; ++q) {
            const int e = C.tid + q * NTHR, ww = e >> 10, i = (e >> 4) & 63, c8 = (e & 15) * 8;
            float f[8]; unpack8(kv[q], f);
            const float be = gm[64 + i];
            if (ww == 0) {
                const float s = be * gm[128 + i];
#pragma unroll
                for (int x = 0; x < 8; ++x) { kf[i * 129 + c8 + x] = f[x]; X[i * XS + 128 + c8 + x] = s * f[x]; }
            } else {
#pragma unroll
                for (int x = 0; x < 8; ++x) X[i * XS + c8 + x] = be * f[x];
            }
        }
        {
            bf16* Pg = (bf16*)(PWS + WS_P) + (((size_t)dir * 128 + cg) * 8 + h) * 4096;
#pragma unroll
            for (int cb = 0; cb < 4; ++cb)
#pragma unroll
                for (int j = 0; j < 4; ++j) {
                    const int i = 16 * rb + 4 * quad + j, jc = 16 * cb + r16;
                    const float dec = (jc <= i) ? __expf(gm[i] - gm[jc]) : 0.f;
                    if (sel == 0) At[jc * 64 + i] = (jc < i) ? gm[64 + i] * acc[cb][j] * dec : 0.f;
                    else Pg[((rb * 2 + (cb >> 1)) * 64 + (2 * (cb & 1) + (r16 >> 3)) * 16 + 4 * quad + j) * 8 + (r16 & 7)] = (bf16)f2bf(acc[cb][j] * dec);
                }
        }
        if (item + stride < nitems) CHK_LOAD(item + stride);
        CHK_BAR();
        {
            const int d = C.tid >> 2, i0 = (C.tid & 3) * 16;
            const float gl = gm[63];
            bf16* dst = (bf16*)(PWS + WS_KDT) + (((size_t)dir * 128 + cg) * 8 + h) * 8192; (void)i0;
#pragma unroll
            for (int q = 0; q < 2; ++q) {
                float f[8];
#pragma unroll
                for (int x = 0; x < 8; ++x) { const int i = i0 + 8 * q + x; f[x] = kf[i * 129 + d] * __expf(gl - gm[i]); }
                { const int p = (C.tid & 3) * 2 + q; *(v4u*)(dst + (size_t)((((d >> 4) * 2 + (p >> 2)) * 64 + (p & 3) * 16 + (d & 15)) * 8)) = pack8(f); }
            }
        }
#pragma unroll
        for (int b = 0; b < 4; ++b) {
            if (b > 0) {
                float av[12], bv0[12], bv1[12]; f32x4g r0, r1;
#pragma unroll
                for (int c = 0; c < b; ++c)
#pragma unroll
                    for (int ks = 0; ks < 4; ++ks) {
                        const int kr = 16 * c + 4 * ks + quad;
                        av[4 * c + ks] = -At[kr * 64 + 16 * b + r16]; bv0[4 * c + ks] = X[kr * XS + 32 * w + r16]; bv1[4 * c + ks] = X[kr * XS + 32 * w + 16 + r16];
                    }
#pragma unroll
                for (int j = 0; j < 4; ++j) { r0[j] = X[(16 * b + 4 * quad + j) * XS + 32 * w + r16]; r1[j] = X[(16 * b + 4 * quad + j) * XS + 32 * w + 16 + r16]; }
                asm volatile("s_waitcnt lgkmcnt(0)" ::: "memory"); __builtin_amdgcn_sched_barrier(0);
#pragma unroll
                for (int q = 0; q < 4 * b; ++q) { r0 = __builtin_amdgcn_mfma_f32_16x16x4f32(av[q], bv0[q], r0, 0, 0, 0); r1 = __builtin_amdgcn_mfma_f32_16x16x4f32(av[q], bv1[q], r1, 0, 0, 0); }
#pragma unroll
                for (int j = 0; j < 4; ++j) { X[(16 * b + 4 * quad + j) * XS + 32 * w + r16] = r0[j]; X[(16 * b + 4 * quad + j) * XS + 32 * w + 16 + r16] = r1[j]; }
                CHK_BAR();
            }
            if (C.tid < 256) {
                float ab[4], x[16];
#pragma unroll
                for (int k = 0; k < 4; ++k) ab[k] = At[(16 * b + 4 * k + quad) * 64 + 16 * b + r16];
#pragma unroll
                for (int r = 0; r < 16; ++r) x[r] = X[(16 * b + r) * XS + C.tid];
                asm volatile("s_waitcnt lgkmcnt(0)" ::: "memory");
#pragma unroll
                for (int c = 0; c < 15; ++c)
#pragma unroll
                    for (int r = c + 1; r < 16; ++r) {
                        const float a = __uint_as_float(__builtin_amdgcn_readlane(__float_as_uint(ab[c >> 2]), ((c & 3) << 4) | r));
                        x[r] -= a * x[c];
                    }
#pragma unroll
                for (int r = 1; r < 16; ++r) X[(16 * b + r) * XS + C.tid] = x[r];
            }
            CHK_BAR();
        }
        {
            float* Ug = (float*)(PWS + WS_U) + (((size_t)dir * 128 + cg) * 8 + h) * 8192;
            bf16* Wg = (bf16*)(PWS + WS_WK) + (((size_t)dir * 128 + cg) * 8 + h) * 8192;
#pragma unroll
            for (int q = 0; q < 4; ++q) { const int e = C.tid + q * NTHR, i0_ = 16 * ((e >> 6) & 3) + 4 * ((e >> 4) & 3), c_ = 16 * (e >> 8) + (e & 15);
                f32x4 v; v[0] = X[i0_ * XS + c_]; v[1] = X[(i0_ + 1) * XS + c_]; v[2] = X[(i0_ + 2) * XS + c_]; v[3] = X[(i0_ + 3) * XS + c_];
                *(f32x4*)(Ug + (size_t)e * 4) = v; }
#pragma unroll
            for (int q = 0; q < 2; ++q) { const int e = C.tid + q * NTHR, i = e >> 4, c8 = (e & 15) * 8; float f[8];
#pragma unroll
                for (int x = 0; x < 8; ++x) f[x] = X[i * XS + 128 + c8 + x];
                { const int p = e & 15; *(v4u*)(Wg + (size_t)((((i >> 4) * 4 + (p >> 2)) * 64 + (p & 3) * 16 + (i & 15)) * 8)) = pack8(f); } }
        }
    }
    asm volatile("s_waitcnt lgkmcnt(0)" ::: "memory");
#undef CHK_LOAD
}
#undef CHK_BAR
DI int gdn_scan_map(int k, int G) {
    const int b_ = k & 255, x_ = b_ & 7, j_ = b_ >> 3; return G == 256 ? (k & ~255) + (((x_ * 4 + (j_ >> 3)) << 3) | (j_ & 7)) : k;
}
DI void gdn_scan_loop(KP P, const Ctx& C, int nit, int T, int l, int g) {
    const int cps = T >> 6;
    const int lane = C.lane, r16 = lane & 15, quad = lane >> 4, w = C.wave, rt = w & 3;
    LAS bf16* St = (LAS bf16*)(C.L + LDS_SCR);
    LAS bf16* Wt = St + 16 * 136;
    const bf16* QC = (const bf16*)(PWS + WS_QC);
    const bf16* WKb = (const bf16*)(PWS + WS_WK); const float* Ub = (const float*)(PWS + WS_U); const bf16* Pb = (const bf16*)(PWS + WS_P); const bf16* KDT = (const bf16*)(PWS + WS_KDT);
    const float* GAM = (const float*)(PWS + WS_GAM);
    bf16x8 afs0[4], pfs0[2], kdfs0[2], afs1[4], pfs1[2], kdfs1[2], afs2[4], pfs2[2], kdfs2[2], afs3[4], pfs3[2], kdfs3[2];
    f32x4g x4s0, x4s1, x4s2, x4s3; float egls0, egls1, egls2, egls3;
#define GDN_LOAD(S, dX, hX, slX, cgx) do { const int cg_ = (cgx); \
        const size_t ib_ = ((size_t)(dX) * 128 + cg_) * 8 + (hX); \
        const bf16* ap = (w < 4 ? WKb : QC) + ib_ * 8192 + (size_t)(rt * 256 + lane) * 8; \
        _Pragma("unroll") for (int kk = 0; kk < 4; ++kk) af##S[kk] = *(const bf16x8*)(ap + 512 * kk); \
        const bf16* pp = Pb + ib_ * 4096 + (w < 4 ? (size_t)0 : (size_t)(rt * 128 + lane) * 8);     \
        pf##S[0] = *(const bf16x8*)pp; pf##S[1] = *(const bf16x8*)(pp + 512); \
        const float* xp = w < 4 ? Ub + ib_ * 8192 + (size_t)(((slX) * 4 + rt) * 64 + lane) * 4 : GAM + ib_ * 64 + 16 * rt + 4 * quad; \
        x4##S = *(const f32x4g*)xp; \
        { const bf16* kp = KDT + ib_ * 8192 + (size_t)(w * 128 + lane) * 8; kdf##S[0] = *(const bf16x8*)kp; kdf##S[1] = *(const bf16x8*)(kp + 512); \
          egl##S = GAM[ib_ * 64 + 63]; } } while (0)
#define GDN_BAR() asm volatile("s_waitcnt lgkmcnt(0)\n\ts_barrier" ::: "memory")
#define GDN_BODY(CUR, NXT, clx) do { const int cl_ = (clx), cgb = seq * cps + cl_, cq_ = cl_ + 3; const bool same_ = cq_ < cps; \
        if (same_ || has_next) GDN_LOAD(NXT, same_ ? dir : dir2, same_ ? h : h2, same_ ? sl : sl2, same_ ? seq * cps + cq_ : seq2 * cps + cq_ - cps); \
        GDN_BAR();                                                  \
        bf16x8 sb[4]; \
        _Pragma("unroll") for (int kk = 0; kk < 4; ++kk) sb[kk] = *(const LAS bf16x8*)(St + r16 * 136 + 32 * kk + 8 * quad); \
        f32x4g acc = (f32x4g){0.f, 0.f, 0.f, 0.f}; \
        _Pragma("unroll") for (int kk = 0; kk < 4; ++kk) acc = __builtin_amdgcn_mfma_f32_16x16x32_bf16(af##CUR[kk], sb[kk], acc, 0, 0, 0); \
        if (w < 4) { const f32x4g wv = x4##CUR - acc; v2u o; o.x = pk2(wv[0], wv[1]); o.y = pk2(wv[2], wv[3]); *(LAS v2u*)(Wt + r16 * 72 + 16 * rt + 4 * quad) = o; } \
        else { _Pragma("unroll") for (int j = 0; j < 4; ++j) acc[j] *= __expf(x4##CUR[j]); } \
        GDN_BAR();                                                  \
        bf16x8 wb[2]; \
        wb[0] = *(const LAS bf16x8*)(Wt + r16 * 72 + 8 * quad); wb[1] = *(const LAS bf16x8*)(Wt + r16 * 72 + 32 + 8 * quad); \
        if (w >= 4) { \
            acc = __builtin_amdgcn_mfma_f32_16x16x32_bf16(pf##CUR[0], wb[0], acc, 0, 0, 0); \
            acc = __builtin_amdgcn_mfma_f32_16x16x32_bf16(pf##CUR[1], wb[1], acc, 0, 0, 0); \
            _Pragma("unroll") for (int j = 0; j < 4; ++j) { const size_t tok = (size_t)gdn_tok(cgb, 16 * rt + 4 * quad + j, dir, T); OG[tok * 1024 + h * 128 + v0 + r16] = acc[j]; } \
        } \
        sreg = sreg * __expf(egl##CUR); \
        sreg = __builtin_amdgcn_mfma_f32_16x16x32_bf16(kdf##CUR[0], wb[0], sreg, 0, 0, 0); \
        sreg = __builtin_amdgcn_mfma_f32_16x16x32_bf16(kdf##CUR[1], wb[1], sreg, 0, 0, 0); \
        { v2u o; o.x = pk2(sreg[0], sreg[1]); o.y = pk2(sreg[2], sreg[3]); *(LAS v2u*)(St + r16 * 136 + 16 * w + 4 * quad) = o; } } while (0)
    int k = C.bid;
    if (k < nit) {
        int sl, dir, h, seq;
        { const int it0 = gdn_scan_map(k, C.G); sl = it0 & 7; dir = (it0 >> 3) & 1; h = (it0 >> 4) & 7; seq = it0 >> 7; }
        GDN_LOAD(s0, dir, h, sl, seq * cps); GDN_LOAD(s1, dir, h, sl, seq * cps + 1); GDN_LOAD(s2, dir, h, sl, seq * cps + 2);
        for (; k < nit; k += C.G) {
            const bool has_next = k + C.G < nit;
            const int itn = gdn_scan_map(has_next ? k + C.G : k, C.G);
            const int sl2 = itn & 7, dir2 = (itn >> 3) & 1, h2 = (itn >> 4) & 7, seq2 = itn >> 7;
            const int v0 = 16 * sl;
            float* OG = (float*)(PWS + (dir ? WS_OGB : WS_OGF));
            f32x4g sreg;
            {
                const int b = g > 0 ? 2 * (g - 1) + seq : 0;
                const float* S0 = PIN(4) + ((((size_t)b * 2 + l) * 2 + dir) * 8 + h) * 16384;
#pragma unroll
                for (int j = 0; j < 4; ++j) sreg[j] = g > 0 ? S0[(size_t)(16 * w + 4 * quad + j) * 128 + v0 + r16] : 0.f;
            }
            GDN_BAR();
            { v2u o; o.x = pk2(sreg[0], sreg[1]); o.y = pk2(sreg[2], sreg[3]); *(LAS v2u*)(St + r16 * 136 + 16 * w + 4 * quad) = o; }
            for (int c = 0; c < cps; c += 4) {
                GDN_BODY(s0, s3, c);
                GDN_BODY(s1, s0, c + 1);
                GDN_BODY(s2, s1, c + 2);
                GDN_BODY(s3, s2, c + 3);
            }
            if (g == 0) {
                float* So = POUT + O_GST + ((((size_t)seq * 2 + l) * 2 + dir) * 8 + h) * 16384;
#pragma unroll
                for (int j = 0; j < 4; ++j) So[(size_t)(16 * w + 4 * quad + j) * 128 + v0 + r16] = sreg[j];
            }
            sl = sl2; dir = dir2; h = h2; seq = seq2;
        }
    }
    asm volatile("s_waitcnt lgkmcnt(0)" ::: "memory");
#undef GDN_BODY
#undef GDN_BAR
#undef GDN_LOAD
}
#ifndef ATT_PLAIN_SDEPTH
#define ATT_PLAIN_SDEPTH 1
#endif
template <int WHICH  > DI void step_mixa(KP P, const Ctx& C, int l, int g) {
    char* lds = (char*)C.lg + LDS_SCR;
    LAS float* biasl = (LAS float*)(C.L + LDS_SCR + at2::SHM_ATTN);
    const bf16* SEG = (const bf16*)(PWS + WS_SEG);
    const bf16 *NAQ = SEG, *NAK = SEG + SEGSZ, *NAV = SEG + 2 * SEGSZ, *DV = SEG + 9 * SEGSZ;
    const bf16 *DQ = g == 0 ? SEG + 7 * SEGSZ : (const bf16*)(PWS + WS_DQR), *DK = g == 0 ? SEG + 8 * SEGSZ : (const bf16*)(PWS + WS_DKR);
    bf16* DOb = (bf16*)(PWS + WS_DO); bf16* ONA = (bf16*)(PWS + WS_ONA);
    const bf16 *CKNA = (const bf16*)(PWS + WS_CKNA), *CVNA = (const bf16*)(PWS + WS_CVNA), *CKD = (const bf16*)(PWS + WS_CKD), *CVD = (const bf16*)(PWS + WS_CVD);
    if constexpr (WHICH < 2) {
    const int u_lo = WHICH == 0 ? 0 : 512, u_hi = WHICH == 0 ? (g == 0 ? 768 : 512) : (g == 0 ? 512 : 768);
    for (int u = u_lo + C.bid; u < u_hi; u += C.G) {
        __syncthreads();
        at2::NaMask mk; mk.on = 0; mk.r0 = 0; mk.kr_lo = 0; mk.bias = biasl;
        const bf16 *Q, *K1, *V1, *K2, *V2; bf16* O; int n1, n2, ldo;
        if (g == 0) {
            if (u < 512) {
                const int ph = u & 15, b = u >> 4, hm = ph >> 1, h = ph >> 2, half = ph & 1;
                Q = DQ + (size_t)(b * 256) * 1024 + hm * 128; K1 = DK + (size_t)(b * 256) * 1024 + hm * 128; V1 = DV + (size_t)(b * 256) * 1024 + h * 256 + half * 128;
                n1 = 256; n2 = 0; K2 = K1; V2 = V1; O = DOb + (size_t)(b * 256) * 2048 + ph * 128; ldo = 2048;
            } else {
                const int u2 = u - 512, h = u2 & 7, b = u2 >> 3;
                Q = NAQ + (size_t)(b * 256) * 1024 + h * 128; K1 = NAK + (size_t)(b * 256) * 1024 + h * 128; V1 = NAV + (size_t)(b * 256) * 1024 + h * 128;
                n1 = 256; n2 = 0; K2 = K1; V2 = V1; O = ONA + (size_t)(b * 256) * 1024 + h * 128; ldo = 1024;
            }
        } else {
            if (u < 512) {
                int qb = u & 15, ph = (u >> 4) & 15, bl = u >> 8;
                if (C.G == 256) { const int x_ = C.bid & 7, j_ = C.bid >> 3; bl = u >> 8; ph = 2 * x_ + (j_ >> 4); qb = j_ & 15; }
                const int b = 2 * (g - 1) + bl, hm = ph >> 1, h = ph >> 2, half = ph & 1;
                Q = DQ + (size_t)(bl * 4096 + qb * 256) * 1024 + hm * 128;
                K1 = DK + (size_t)(bl * 4096) * 1024 + hm * 128; V1 = DV + (size_t)(bl * 4096) * 1024 + h * 256 + half * 128; n1 = 4096;
                K2 = CKD + (size_t)((b * 2 + l) * 256) * 1024 + hm * 128; V2 = CVD + (size_t)((b * 2 + l) * 256) * 1024 + h * 256 + half * 128; n2 = 256;
                O = DOb + (size_t)(bl * 4096 + qb * 256) * 2048 + ph * 128; ldo = 2048;
            } else {
                const int u2 = u - 512; int qb = u2 & 15, h = (u2 >> 4) & 7, bl = u2 >> 7;
                if (C.G == 256) { const int x_ = C.bid & 7, j_ = C.bid >> 3; h = x_; bl = j_ >> 4; qb = j_ & 15; }
                const int b = 2 * (g - 1) + bl;
                const int r0 = 4 * qb;
                int kr_lo = min(max(r0 - 4, 0), 56), kr_hi = min(max(r0 - 1, 0), 56) + 8;
                if ((kr_hi - kr_lo) & 1) { if (kr_hi < 64) ++kr_hi; else --kr_lo; }
                Q = NAQ + (size_t)(bl * 4096 + qb * 256) * 1024 + h * 128;
                K1 = CKNA + (size_t)((b * 2 + l) * 256) * 1024 + h * 128; V1 = CVNA + (size_t)((b * 2 + l) * 256) * 1024 + h * 128; n1 = 256;
                K2 = NAK + (size_t)(bl * 4096 + kr_lo * 64) * 1024 + h * 128; V2 = NAV + (size_t)(bl * 4096 + kr_lo * 64) * 1024 + h * 128; n2 = 64 * (kr_hi - kr_lo);
                O = ONA + (size_t)(bl * 4096 + qb * 256) * 1024 + h * 128; ldo = 1024;
                mk.on = 1; mk.r0 = r0; mk.kr_lo = kr_lo;
                { int e = threadIdx.x; asm volatile("" : "+v"(e)); if (e < 465) biasl[e] = PIN(18)[(size_t)(l * 8 + h) * 465 + e]; }
            }
        }
        at2::attn_body<WHICH == 1, (WHICH == 1 ? 1 : ATT_PLAIN_SDEPTH)>(Q, K1, V1, n1, K2, V2, n2, O, ldo, lds, mk);
    }
    } else {
    const int T = g == 0 ? CT : LT;
    __syncthreads();
    gdn_chunk_loop(P, C, C.bid, 2048, C.G, T);
    __syncthreads();
    }
}


struct BranchOrder {
    pg8::StaticOrder S0;
    DI bool next(int i, pg8::Unit& u) const { const int r = i / 3, b = i - 3 * r; pg8::Unit t; if (!S0.next(r, t)) return false; u.pm = 32 * b + t.pm; u.pn = 8 * b + t.pn; return true; }
    DI void a_ready(const pg8::Unit&) const {}
    DI void done(const pg8::Unit&) const {}
};
__global__ void __launch_bounds__(NTHR, 2) mk_fwd(Params P0) {
    KP P = (KP)__builtin_amdgcn_kernarg_segment_ptr();
    extern __shared__ __attribute__((aligned(16))) unsigned char lds_raw[];
    volatile LAS unsigned* MISC = (volatile LAS unsigned*)((LAS unsigned char*)lds_raw + LDS_MISC);
    for (int u = threadIdx.x; u < 256; u += NTHR) MISC[u] = 0u;
    __syncthreads();
    unsigned* barw = (unsigned*)(PWS + WS_CTL) + 4096;
#ifndef DUP_GEMM
#define DUP_GEMM 1
#endif
#ifndef DUP_ATTN
#define DUP_ATTN 1
#endif
#ifndef DUP_GDN
#define DUP_GDN 1
#endif
#define LI(x) ({ int v_ = (x); asm volatile("" : "+s"(v_)); v_; })
#define STEP_CTX KP P; Ctx C; { KP kp_ = (KP)__builtin_amdgcn_kernarg_segment_ptr(); asm volatile("" : "+s"(kp_)); P = kp_; \
    int t_ = threadIdx.x, b_ = blockIdx.x; asm volatile("" : "+v"(t_)); asm volatile("" : "+s"(b_)); \
    C.tid = t_; C.lane = t_ & 63; C.wave = __builtin_amdgcn_readfirstlane(t_ >> 6); C.G = gridDim.x; C.bid = b_; C.gw = C.bid * NWAVES + C.wave; C.ngw = C.G * NWAVES; \
    LAS unsigned char* lp_ = (LAS unsigned char*)lds_raw; asm volatile("" : "+s"(lp_)); C.L = lp_; C.lg = (unsigned char*)lp_; } \
    PG8_LAS unsigned char* ring = (PG8_LAS unsigned char*)(C.L + LDS_SCR); const bf16* WT = (const bf16*)(PWS + WS_WT); \
    bf16* H = (bf16*)(PWS + WS_H); bf16* Y = (bf16*)(PWS + WS_Y); bf16* ACT = (bf16*)(PWS + WS_ACT); (void)ring; (void)WT; (void)H; (void)Y; (void)ACT;
#if MK_ONE_LAUNCH
    XcdBarrier bar = xcd_barrier_post(barw, MISC + 8);
#define GRID_BAR() do { XcdBarrier b2_ = bar; asm volatile("" : "+s"(b2_.bar)); xcd_barrier(b2_); } while (0)
#define GRID_BAR_F() ([&]() { GRID_BAR(); return 0; }())
#else
#define GRID_BAR() do { } while (0)
#define GRID_BAR_F() 0
#endif
    const int s_lo = P->s_lo, s_hi = P->s_hi;
    int step = 0;
#define RUN (step >= s_lo && step < s_hi)
#define REPFOR(k) for (int r_ = 0, n_ = RUN ? P->rep[k] : 0; r_ < n_; ++r_) if (r_ > 0 && (GRID_BAR_F(), false)) {} else
#define NEXT do { if (RUN && step + 1 < s_hi) { GRID_BAR(); } ++step; } while (0)

    for (int l = 0; l < 2; ++l) {
        REPFOR(0) { STEP_CTX step_weights(P, C, l); if (l == 0) { step_modpartial(P, C); step_caches(P, C); } __syncthreads(); }
        NEXT;
        if (l == 0) {
            if (RUN) { STEP_CTX step_modreduce(P, C); }
            NEXT;
            REPFOR(1) { STEP_CTX step_rows<1, 0>(P, C, 0, -1, 0.f, 0, 0); }
            NEXT;
        }
        for (int f = 0; f < 2; ++f) {
            REPFOR(2) { STEP_CTX
                pg8::Gemm gm{H, WT + (f ? WT_GU2 : WT_GU1), MTOT, 2 * DFF, DM}; pg8::StaticOrder S; S.init(MTOT, 2 * DFF, C.G, C.bid);
                EpiSwiGLU E{ACT};
                pg8::gemm_phase<EpiSwiGLU, pg8::StaticOrder, true, true>(ring, gm, S, E);
            }
            NEXT;
            REPFOR(3) { STEP_CTX
                pg8::Gemm gm{ACT, WT + (f ? WT_DN2 : WT_DN1), MTOT, DM, DFF}; pg8::StaticOrder S; S.init(MTOT, DM, C.G, C.bid);
                EpiBf16Out E{Y, DM};
                pg8::gemm_phase<EpiBf16Out, pg8::StaticOrder, true, true>(ring, gm, S, E);
            }
            NEXT;
            if (f == 0) {
                if (RUN) { STEP_CTX if (l == 0) step_rows<1, 0>(P, C, l, 0, 0.5f, l, 1); else step_rows<0, 0>(P, C, l, 0, 0.5f, l, 1); }
                NEXT;
                for (int g = 0; g <= NGRP; ++g) {
                    if (g >= 1) {
                    REPFOR(10) { STEP_CTX
                        pg8::Gemm gm{(const bf16*)(PWS + WS_MRGB), WT + WT_OUT, MG, DM, DM}; pg8::StaticOrder S; S.init(MG, DM, C.G, C.bid);
                        EpiBf16Out E{Y + (size_t)(g - 1) * MG * DM, DM};
                        pg8::gemm_phase<EpiBf16Out, pg8::StaticOrder, true, true>(ring, gm, S, E);
                    }
                    }
                    if (g < NGRP) {
                    REPFOR(4) { STEP_CTX
                        pg8::Gemm gm{H + (size_t)g * MG * DM, WT + WT_IN, MG, 16384, DM}; pg8::StaticOrder S; S.init(MG, 16384, C.G, C.bid);
                        EpiWin E{(bf16*)(PWS + WS_SEG), (bf16*)(PWS + WS_GATES), POUT, g == 0 ? 1 : 0, l};
                        pg8::gemm_phase<EpiWin, pg8::StaticOrder, true, true>(ring, gm, S, E);
                    }
                    }
                    NEXT;
                    if (g == NGRP) break;
                    REPFOR(11) { STEP_CTX step_prep(P, C, LI(l), LI(g)); }
                    NEXT;
                    REPFOR(5) { { STEP_CTX step_mixa<0>(P, C, LI(l), LI(g)); } if (g > 0) { STEP_CTX step_mixa<1>(P, C, LI(l), LI(g)); } }
                    REPFOR(6) { STEP_CTX step_mixa<2>(P, C, LI(l), LI(g)); }
                    NEXT;
                    REPFOR(7) { STEP_CTX const int T = g == 0 ? CT : LT, nit = (MG / T) * 128; __syncthreads(); gdn_scan_loop(P, C, nit, T, LI(l), LI(g)); }
                    NEXT;
                    REPFOR(8) { STEP_CTX step_post(P, C, LI(l)); }
                    NEXT;
                    REPFOR(9) { STEP_CTX
                        {
                        pg8::Gemm gm{(const bf16*)(PWS + WS_ONA), WT + WT_BR, 3 * MG, 3 * DM, 1024}; BranchOrder S; S.S0.init(MG, DM, C.G, C.bid);
                        EpiBranch E{(const bf16*)(PWS + WS_GATES), (bf16*)(PWS + WS_MRG), (bf16*)(PWS + WS_MRGB)};
                        pg8::gemm_phase<EpiBranch, BranchOrder, true, true>(ring, gm, S, E);
                        }
                    }
                    NEXT;
                }
                if (RUN) { STEP_CTX step_rows<0, 0>(P, C, l, 1, 1.0f, l, 2); }
                NEXT;
            } else {
                if (RUN) { STEP_CTX if (l == 0) step_rows<0, 0>(P, C, l, 2, 0.5f, l + 1, 0); else step_rows<0, 1>(P, C, l, 2, 0.5f, l + 1, -1); }
                NEXT;
            }
        }
    }
    for (int i_ = 0, n_ = (P->rep[12] - 1) * 100; i_ < n_; ++i_) { GRID_BAR(); }
#undef RUN
#undef NEXT
}
constexpr int NSTEPS = 80;

extern "C" void kernel_launch(void* const* d_in, const int* in_sizes, int n_in, void* d_out, int out_size, void* d_ws, size_t ws_size, hipStream_t stream) {
    static int grid = 0;
    if (grid == 0) {
        if (n_in != 29 || (size_t)out_size != O_END || ws_size < WS_END) {
            fprintf(stderr, "kernel_launch: built for 29 inputs, %zu outputs, >= %zu bytes of workspace; got n_in %d out %d ws %zu; nothing launched\n", (size_t)O_END, (size_t)WS_END, n_in, out_size, ws_size);
            grid = -1; return; }
        int dev = 0, cus = 0, per_cu = 0;
        if (hipGetDevice(&dev) != hipSuccess || hipDeviceGetAttribute(&cus, hipDeviceAttributeMultiprocessorCount, dev) != hipSuccess) { grid = -1; return; }
        if (hipFuncSetAttribute((const void*)mk_fwd, hipFuncAttributeMaxDynamicSharedMemorySize, LDS_BYTES) != hipSuccess) { fprintf(stderr, "kernel_launch: hipFuncSetAttribute failed\n"); grid = -1; return; }
        if (hipOccupancyMaxActiveBlocksPerMultiprocessor(&per_cu, (const void*)mk_fwd, NTHR, LDS_BYTES) != hipSuccess || per_cu < 1)
            fprintf(stderr, "kernel_launch: note: occupancy query reports %d workgroups per CU\n", per_cu);
        (void)hipGetLastError();
        grid = cus;
    }
    if (grid < 0) return;
    if (hipMemsetAsync((char*)d_ws + WS_CTL, 0, CTL_ZERO_BYTES, stream) != hipSuccess) { fprintf(stderr, "kernel_launch: memset failed\n"); return; }
    Params p{};
    for (int i = 0; i < 16; ++i) p.rep[i] = 1;
#ifdef PROBE_REP
    p.rep[PROBE_REP] = 2;
#endif
    for (int i = 0; i < 29; ++i) p.in[i] = (const float*)d_in[i];
    p.out = (float*)d_out; p.ws = (unsigned char*)d_ws;
#if MK_ONE_LAUNCH
    p.s_lo = 0; p.s_hi = NSTEPS;
    hipLaunchKernelGGL(mk_fwd, dim3(grid), dim3(NTHR), LDS_BYTES, stream, p);
#else
    for (int s = 0; s < NSTEPS; ++s) { p.s_lo = s; p.s_hi = s + 1; hipLaunchKernelGGL(mk_fwd, dim3(grid), dim3(NTHR), LDS_BYTES, stream, p); }
#endif
    const hipError_t le = hipPeekAtLastError();
    if (le != hipSuccess) fprintf(stderr, "kernel_launch: launch failed: %s\n", hipGetErrorName(le));
}
```

```cpp
#include <hip/hip_runtime.h>
#include <cstdio>
#include <cstdint>
#ifndef MK_ONE_LAUNCH
#define MK_ONE_LAUNCH 1
#endif
#define AT2_SDEPTH 1
namespace pg8 {
#define PG8_LAS __attribute__((address_space(3)))
typedef unsigned short bf16_t;
typedef short bf16x8 __attribute__((ext_vector_type(8)));
typedef float f32x4 __attribute__((ext_vector_type(4)));
typedef unsigned u32x4 __attribute__((ext_vector_type(4)));
constexpr int BM = 256, BK = 64, HALF = 128, HTB = HALF * BK * 2  , STAGE_BYTES = 8 * HTB, NXCD = 8, WGM = 8;

__host__ __device__ __forceinline__ int lds_byte(int r, int c) { const int st = (r >> 4) * 2 + (c >> 5), rr = r & 15, cc = c & 31, ob = rr * 64 + cc * 2; return st * 1024 + (ob ^ (((ob >> 9) & 1) << 5)); }
__host__ __device__ __forceinline__ void stage_rc(int b, int& R, int& C) { const int st = b / 1024, sb = b % 1024, swz = sb ^ (((sb >> 9) & 1) << 5); R = (st >> 1) * 16 + swz / 64; C = (st & 1) * 32 + (swz % 64) / 2; }
__host__ __device__ __forceinline__ int perm32(int rho) { const int n = rho >> 4, i = rho & 15; return 8 * (i >> 2) + 4 * n + (i & 3); }

struct Unit { int pm, pn; };
struct Gemm { const bf16_t* A; const bf16_t* Bt; int M, N, K; };

struct StaticOrder {
    int nM, nN, nwg, G, c;
    __host__ __device__ void init(int M, int N, int G_, int c_) { nM = M / BM; nN = N / BM; nwg = nM * nN; G = G_; c = c_; }
    __host__ __device__ bool next(int i, Unit& u) const {
        const long L = (long)i * G + c; if (L >= nwg) return false;
        int wgid = (int)L; { const int q = nwg / NXCD, r = nwg % NXCD, xcd = wgid % NXCD, off = wgid / NXCD; wgid = (xcd < r ? xcd * (q + 1) : r * (q + 1) + (xcd - r) * q) + off; }
        const int nig = WGM * nN, gid = wgid / nig, fm = gid * WGM, gsz = (nM - fm) < WGM ? (nM - fm) : WGM;
        u.pm = fm + ((wgid % nig) % gsz); u.pn = (wgid % nig) / gsz; return true;
    }
    __device__ __forceinline__ void a_ready(const Unit&) const {}
    __device__ __forceinline__ void done(const Unit&) const {}
};
__device__ __forceinline__ unsigned cvt_pk_bf16(float lo, float hi) { unsigned r; asm volatile("v_cvt_pk_bf16_f32 %0, %1, %2" : "=v"(r) : "v"(lo), "v"(hi)); return r; }
template <class Epi, class Sched, bool ALIGN_EPI = false, bool SP2 = false>
__device__ __forceinline__ void gemm_phase(PG8_LAS unsigned char* lds, const Gemm g, const Sched& S, const Epi& E) {
    int tid_l = threadIdx.x; asm volatile("" : "+v"(tid_l));
    const int tid = tid_l, wid = __builtin_amdgcn_readfirstlane(tid >> 6), lane = tid & 63, wr = wid >> 2, wc = wid & 3, fr = lane & 15, fq = lane >> 4;
    const int K = g.K, nt = K / BK;
    unsigned voffA[2], voffB[2];
#pragma unroll
    for (int i = 0; i < 2; ++i) { int R, C; stage_rc(tid * 16 + i * 8192, R, C); const int Rb = (int)Epi::PERM == 2 ? (64 * (R >> 5) + perm32(R & 31)) : (Epi::PERM ? ((R & ~31) + perm32(R & 31)) : R);
        voffA[i] = (unsigned)(R * K + C) * 2u; voffB[i] = (unsigned)(Rb * K + C) * 2u; }
    const size_t kstep = (size_t)(BK * 2);
    const size_t hstep = (size_t)HALF * K * 2;
    const size_t hstepB = (int)Epi::PERM == 2 ? (size_t)32 * K * 2 : hstep;
    const size_t tstep = 2 * hstep;
    const unsigned ldsw = (unsigned)wid * 1024u;
    const int aoff = lds_byte(wr * 64 + fr, fq * 8), boff = lds_byte(wc * 32 + fr, fq * 8);
#define PG8_SA(b, h) (((b) * 2 + (h)) * HTB)
#define PG8_SB(b, h) ((4 + (b) * 2 + (h)) * HTB)
#define PG8_STAGE(bufoff, gbase, voff) do { _Pragma("unroll") for (int _i = 0; _i < 2; ++_i) \
        __builtin_amdgcn_global_load_lds((const unsigned*)((const char*)(gbase) + (voff)[_i]), (PG8_LAS unsigned*)(lds + (bufoff) + ldsw + _i * 8192), 16, 0, 0); } while (0)
#define PG8_LDA(dst, b, h) do { _Pragma("unroll") for (int m = 0; m < 4; ++m) _Pragma("unroll") for (int k = 0; k < 2; ++k) dst[m][k] = *(const PG8_LAS bf16x8*)(lds + PG8_SA(b, h) + aoff + m * 2048 + k * 1024); } while (0)
#define PG8_LDB(dst, b, h) do { _Pragma("unroll") for (int n = 0; n < 2; ++n) _Pragma("unroll") for (int k = 0; k < 2; ++k) dst[n][k] = *(const PG8_LAS bf16x8*)(lds + PG8_SB(b, h) + boff + n * 2048 + k * 1024); } while (0)
#define PG8_MMA(ai, bj, At, Bt) do { __builtin_amdgcn_s_setprio(1); _Pragma("unroll") for (int m = 0; m < 4; ++m) _Pragma("unroll") for (int n = 0; n < 2; ++n) _Pragma("unroll") for (int k = 0; k < 2; ++k) \
        acc[ai][bj][m][n] = __builtin_amdgcn_mfma_f32_16x16x32_bf16(Bt[n][k], At[m][k], acc[ai][bj][m][n], 0, 0, 0); __builtin_amdgcn_s_setprio(0); } while (0)
#define PG8_WAIT_V(n) asm volatile("s_waitcnt vmcnt(" #n ")" ::: "memory")
#define PG8_WAIT_L(n) asm volatile("s_waitcnt lgkmcnt(" #n ")" ::: "memory")
#define PG8_BAR __builtin_amdgcn_s_barrier()
#define PG8_SCHED __builtin_amdgcn_sched_barrier(0)
    Unit cur, nxt; int ui = 0;
    if (!S.next(0, cur)) return;
    f32x4 acc[2][2][4][2];
#pragma unroll
    for (int a = 0; a < 2; ++a)
#pragma unroll
        for (int b = 0; b < 2; ++b)
#pragma unroll
            for (int m = 0; m < 4; ++m)
#pragma unroll
                for (int n = 0; n < 2; ++n) acc[a][b][m][n] = (f32x4){0.f, 0.f, 0.f, 0.f};
    bf16x8 At[4][2], B0[2][2], B1[2][2];
    const char* cA = (const char*)g.A + (size_t)cur.pm * tstep; const char* cB = (const char*)g.Bt + (size_t)cur.pn * tstep;
    S.a_ready(cur);
    if constexpr (SP2) {
        PG8_STAGE(PG8_SB(0, 0), cB, voffB); PG8_STAGE(PG8_SB(0, 1), cB + hstepB, voffB); PG8_STAGE(PG8_SA(0, 0), cA, voffA); PG8_STAGE(PG8_SA(0, 1), cA + hstep, voffA);
        if (wr == 1) PG8_BAR;
        PG8_WAIT_V(2); PG8_BAR;
        PG8_STAGE(PG8_SB(1, 0), cB + kstep, voffB); PG8_STAGE(PG8_SA(1, 0), cA + kstep, voffA); PG8_STAGE(PG8_SB(1, 1), cB + hstepB + kstep, voffB);
        PG8_WAIT_V(6); PG8_BAR;
    } else {
        PG8_STAGE(PG8_SB(0, 0), cB, voffB); PG8_STAGE(PG8_SA(0, 0), cA, voffA); PG8_STAGE(PG8_SB(0, 1), cB + hstepB, voffB); PG8_STAGE(PG8_SA(0, 1), cA + hstep, voffA);
        if (wr == 1) PG8_BAR;
        PG8_WAIT_V(4); PG8_BAR;
        PG8_STAGE(PG8_SB(1, 0), cB + kstep, voffB); PG8_STAGE(PG8_SA(1, 0), cA + kstep, voffA); PG8_STAGE(PG8_SB(1, 1), cB + hstepB + kstep, voffB);
        PG8_WAIT_V(6); PG8_BAR;
    }
    for (;;) {
        const bool has_next = S.next(ui + 1, nxt);
        const char* nA = has_next ? (const char*)g.A + (size_t)nxt.pm * tstep : cA; const char* nB = has_next ? (const char*)g.Bt + (size_t)nxt.pn * tstep : cB;
        for (int t = 0; t < nt; t += 2) {
            const bool last = (t == nt - 2);
            const char* a1 = cA + (size_t)(t + 1) * kstep;
            const char* a2 = last ? nA : cA + (size_t)(t + 2) * kstep; const char* b2 = last ? nB : cB + (size_t)(t + 2) * kstep;
            const char* a3 = a2 + kstep; const char* b3 = b2 + kstep;
            if (last && has_next) S.a_ready(nxt);
            if constexpr (SP2) {
            PG8_LDB(B0, 0, 0); PG8_LDB(B1, 0, 1); PG8_SCHED; PG8_LDA(At, 0, 0); PG8_STAGE(PG8_SA(1, 1), a1 + hstep, voffA);
            PG8_WAIT_V(8); PG8_WAIT_L(0); PG8_BAR; PG8_MMA(0, 0, At, B0); PG8_MMA(0, 1, At, B1); PG8_BAR; PG8_SCHED;
            PG8_LDA(At, 0, 1); PG8_STAGE(PG8_SB(0, 0), b2, voffB); PG8_STAGE(PG8_SB(0, 1), b2 + hstepB, voffB); PG8_STAGE(PG8_SA(0, 0), a2, voffA);
            PG8_WAIT_V(8); PG8_WAIT_L(0); PG8_BAR; PG8_MMA(1, 0, At, B0); PG8_MMA(1, 1, At, B1); PG8_BAR; PG8_SCHED;
            PG8_LDB(B0, 1, 0); PG8_LDB(B1, 1, 1); PG8_SCHED; PG8_LDA(At, 1, 0); PG8_STAGE(PG8_SA(0, 1), a2 + hstep, voffA);
            PG8_WAIT_V(8); PG8_WAIT_L(0); PG8_BAR; PG8_MMA(0, 0, At, B0); PG8_MMA(0, 1, At, B1); PG8_BAR; PG8_SCHED;
            PG8_LDA(At, 1, 1); PG8_STAGE(PG8_SB(1, 0), b3, voffB); PG8_STAGE(PG8_SB(1, 1), b3 + hstepB, voffB); PG8_STAGE(PG8_SA(1, 0), a3, voffA);
            PG8_WAIT_V(8); PG8_WAIT_L(0); PG8_BAR; PG8_MMA(1, 0, At, B0); PG8_MMA(1, 1, At, B1); PG8_BAR; PG8_SCHED;
            } else {
            PG8_LDB(B0, 0, 0); PG8_SCHED; PG8_LDA(At, 0, 0); PG8_STAGE(PG8_SA(1, 1), a1 + hstep, voffA);
            PG8_WAIT_L(8); PG8_BAR; PG8_WAIT_L(0); PG8_MMA(0, 0, At, B0); PG8_BAR; PG8_SCHED;
            PG8_LDB(B1, 0, 1); PG8_STAGE(PG8_SB(0, 0), b2, voffB);
            PG8_BAR; PG8_WAIT_L(0); PG8_MMA(0, 1, At, B1); PG8_BAR;
            PG8_LDA(At, 0, 1); PG8_STAGE(PG8_SA(0, 0), a2, voffA);
            PG8_BAR; PG8_WAIT_L(0); PG8_MMA(1, 0, At, B0); PG8_BAR; PG8_SCHED;
            PG8_STAGE(PG8_SB(0, 1), b2 + hstepB, voffB);
            PG8_WAIT_V(6); PG8_BAR; PG8_MMA(1, 1, At, B1); PG8_BAR;
            PG8_LDB(B0, 1, 0); PG8_SCHED; PG8_LDA(At, 1, 0); PG8_STAGE(PG8_SA(0, 1), a2 + hstep, voffA);
            PG8_WAIT_L(8); PG8_BAR; PG8_WAIT_L(0); PG8_MMA(0, 0, At, B0); PG8_BAR; PG8_SCHED;
            PG8_LDB(B1, 1, 1); PG8_STAGE(PG8_SB(1, 0), b3, voffB);
            PG8_BAR; PG8_WAIT_L(0); PG8_MMA(0, 1, At, B1); PG8_BAR;
            PG8_LDA(At, 1, 1); PG8_STAGE(PG8_SA(1, 0), a3, voffA);
            PG8_BAR; PG8_WAIT_L(0); PG8_MMA(1, 0, At, B0); PG8_BAR; PG8_SCHED;
            PG8_STAGE(PG8_SB(1, 1), b3 + hstepB, voffB);
            PG8_WAIT_V(6); PG8_BAR; PG8_MMA(1, 1, At, B1); PG8_BAR;
            }
        }
        if constexpr (ALIGN_EPI) { if (wr == 0) PG8_BAR; }
        if constexpr (!Epi::AFTER_DRAIN) { E(acc, cur, wr, wc, fr, fq); S.done(cur); }
        if (!has_next) break;
        {
#pragma unroll
        for (int a = 0; a < 2; ++a)
#pragma unroll
            for (int b = 0; b < 2; ++b)
#pragma unroll
                for (int m = 0; m < 4; ++m)
#pragma unroll
                    for (int n = 0; n < 2; ++n) acc[a][b][m][n] = (f32x4){0.f, 0.f, 0.f, 0.f};
        }
        cur = nxt; cA = nA; cB = nB; ++ui;
        if constexpr (ALIGN_EPI) { if (wr == 1) PG8_BAR; }
    }
    PG8_WAIT_V(0);
    if constexpr (!ALIGN_EPI) { if (wr == 0) PG8_BAR; }
    PG8_BAR;
    if constexpr (Epi::AFTER_DRAIN) { E.fused(acc, cur, wr, wc, fr, fq, lds, wid, lane); S.done(cur); }
#undef PG8_SA
#undef PG8_SB
#undef PG8_STAGE
#undef PG8_LDA
#undef PG8_LDB
#undef PG8_MMA
#undef PG8_WAIT_V
#undef PG8_WAIT_L
#undef PG8_BAR
#undef PG8_SCHED
}
}

#define GAS __attribute__((address_space(1)))
#define LAS __attribute__((address_space(3)))
#define DI __device__ __forceinline__
typedef unsigned short bf16;
typedef unsigned v4u __attribute__((ext_vector_type(4)));
typedef unsigned v2u __attribute__((ext_vector_type(2)));
typedef float f32x4 __attribute__((ext_vector_type(4)));
typedef float f32x2 __attribute__((ext_vector_type(2)));
typedef short bf16x8 __attribute__((ext_vector_type(8)));
#define LDS_WAIT() asm volatile("s_waitcnt lgkmcnt(0)" ::: "memory")
#define VM_WAIT() asm volatile("s_waitcnt vmcnt(0)" ::: "memory")

constexpr int NWAVES = 8, NTHR = 512;
constexpr int DM = 2048, DFF = 5632, NMODV = 9 * DM;
constexpr int CB = 32, CT = 256, LB = 8, LT = 4096;
constexpr int NCTX = CB * CT, NLAT = LB * LT, MTOT = NCTX + NLAT;
constexpr int MG = 8192, NGRP = 5;
constexpr int NINP = 16640, NINR = 16416;
constexpr float EPSF = 1e-6f;
constexpr float QSCALE = 0.08838834764831845f;

constexpr size_t O_X = 0, O_NAK = 83886080ull, O_NAV = 100663296ull, O_GST = 117440512ull, O_DK = 134217728ull, O_DV = 150994944ull, O_END = 167772160ull;

constexpr size_t WT_GU1 = 0, WT_DN1 = WT_GU1 + (size_t)2 * DFF * DM, WT_GU2 = WT_DN1 + (size_t)DM * DFF, WT_DN2 = WT_GU2 + (size_t)2 * DFF * DM,
                 WT_IN = WT_DN2 + (size_t)DM * DFF, WT_BR = WT_IN + (size_t)NINP * DM, WT_OUT = WT_BR + (size_t)3 * DM * 1024, WT_END = WT_OUT + (size_t)DM * DM;

constexpr size_t MiB = 1ull << 20;
constexpr size_t WS_CTL = 0, CTL_ZERO_BYTES = 1 * MiB;
constexpr size_t WS_MOD = 1 * MiB;
constexpr size_t WS_MODP = 3 * MiB;
constexpr size_t WS_ROPE = 14 * MiB;
constexpr size_t WS_CKNA = 16 * MiB, WS_CVNA = 24 * MiB, WS_CKD = 32 * MiB, WS_CVD = 40 * MiB;
constexpr size_t WS_WT = 48 * MiB;
constexpr size_t WS_H = 268 * MiB;
constexpr size_t WS_Y = 428 * MiB;
constexpr size_t WS_ACT = 748 * MiB;
constexpr size_t WS_SEG = 748 * MiB;
constexpr size_t WS_GATES = 908 * MiB;
constexpr size_t WS_AB = 1004 * MiB, WS_BL = 1005 * MiB;
constexpr size_t WS_QN = 1006 * MiB, WS_KN = 1022 * MiB, WS_VN = 1038 * MiB;
constexpr size_t WS_DO = 1054 * MiB;
constexpr size_t WS_OGF = 1086 * MiB, WS_OGB = 1118 * MiB;
constexpr size_t WS_MRG = 1150 * MiB;
constexpr size_t WS_MRGB = 1214 * MiB;
constexpr size_t WS_ONA = 1246 * MiB, WS_OG = 1262 * MiB, WS_OD = 1278 * MiB;
constexpr size_t WS_U = 1294 * MiB;
constexpr size_t WS_WK = 1358 * MiB;
constexpr size_t WS_KDT = 1390 * MiB;
constexpr size_t WS_P = 1422 * MiB;
constexpr size_t WS_GAM = 1454 * MiB;
constexpr size_t WS_DQR = 1456 * MiB, WS_DKR = 1472 * MiB;
constexpr size_t WS_XB = 1488 * MiB;
constexpr size_t WS_QC = 1648 * MiB;
constexpr size_t WS_END = 1680 * MiB;
static_assert(WS_WT + WT_END * 2 <= WS_H, "weights fit");
constexpr size_t SEGSZ = (size_t)MG * 1024;

constexpr int LDS_MISC = 0;
constexpr int LDS_SCR = 1024;
constexpr int LDS_BYTES = 155648;

DI float bf2f(unsigned b) { return __uint_as_float(b << 16); }
DI unsigned f2bf(float f) { unsigned u = __float_as_uint(f); return (u + 0x7fffu + ((u >> 16) & 1u)) >> 16; }
typedef float f32x2c __attribute__((ext_vector_type(2))); typedef __bf16 bf16x2c __attribute__((ext_vector_type(2)));
DI unsigned pk2(float lo, float hi) { const f32x2c v = {lo, hi}; const bf16x2c b = __builtin_convertvector(v, bf16x2c); return __builtin_bit_cast(unsigned, b); }
DI float wave_sum(float v) {
#pragma unroll
    for (int o = 1; o < 64; o <<= 1) v += __shfl_xor(v, o);
    return v;
}
DI float siluf(float x) { return x * __builtin_amdgcn_rcpf(1.f + __expf(-x)); }
DI float sigmf(float x) { return __builtin_amdgcn_rcpf(1.f + __expf(-x)); }
DI void unpack8(const v4u w, float (&f)[8]) {
    f[0] = bf2f(w.x & 0xffffu); f[1] = bf2f(w.x >> 16); f[2] = bf2f(w.y & 0xffffu); f[3] = bf2f(w.y >> 16);
    f[4] = bf2f(w.z & 0xffffu); f[5] = bf2f(w.z >> 16); f[6] = bf2f(w.w & 0xffffu); f[7] = bf2f(w.w >> 16);
}
DI v4u pack8(const float (&f)[8]) { v4u w; w.x = pk2(f[0], f[1]); w.y = pk2(f[2], f[3]); w.z = pk2(f[4], f[5]); w.w = pk2(f[6], f[7]); return w; }

struct Params {
    const float* in[29];
    float* out; unsigned char* ws;
    int s_lo, s_hi;
    int rep[16];
};
#define CAS __attribute__((address_space(4)))
typedef const CAS Params* KP;
#define PIN(i) ((const float*)(const GAS float*)P->in[i])
#define PWS ((unsigned char*)(GAS unsigned char*)P->ws)
#define POUT ((float*)(GAS float*)P->out)
struct Ctx {
    int tid, lane, wave, G, bid;
    int gw, ngw;
    LAS unsigned char* L;
    unsigned char* lg;
};
#define XB_TMO      128
#define XB_XCNT(j)  (256  + 64 * (j))
#define XB_XSUB(j)  (1280 + 64 * (j))
#define XB_XGEN(j)  (2304 + 64 * (j))
#define XB_TOP      3328
#define XB_TOPGEN   3392
#define XCD_BAR_WORDS 3456
#define XB_SPIN_CAP (1u << 18)

__device__ __forceinline__ unsigned xb_ld(unsigned* p)              { return __hip_atomic_load(p, __ATOMIC_RELAXED, __HIP_MEMORY_SCOPE_AGENT); }
__device__ __forceinline__ unsigned xb_add(unsigned* p, unsigned v) { return __hip_atomic_fetch_add(p, v, __ATOMIC_RELAXED, __HIP_MEMORY_SCOPE_AGENT); }
__device__ __forceinline__ unsigned xb_xcc_id() { return (unsigned)__builtin_amdgcn_s_getreg((3 << 11) | 20) & 0xFu; }
#define XB_SPIN(cond, bar) do { unsigned _sp = 0; while (cond) { __builtin_amdgcn_s_sleep(1); \
    if ((++_sp & 255u) == 0u) { if (xb_ld(&(bar)[XB_TMO])) break; if (_sp > XB_SPIN_CAP) { atomicAdd(&(bar)[XB_TMO], 1u); break; } } } } while (0)

struct XcdBarrier {
    unsigned* bar; unsigned x;
    volatile LAS unsigned* st;
};

__device__ __forceinline__ XcdBarrier xcd_barrier_post(unsigned* bar, volatile LAS unsigned* st) {
    XcdBarrier b; b.bar = bar; b.x = xb_xcc_id(); b.st = st;
    if (threadIdx.x == 0) (void)xb_add(&bar[XB_XCNT(b.x)], 1u);
    return b;
}
__device__ __forceinline__ void xcd_barrier_complete(unsigned* bar, unsigned x, unsigned& nloc, unsigned& nx) {
    const unsigned G = gridDim.x * gridDim.y * gridDim.z;
    unsigned sum, cnt, mine, sp = 0u;
    for (;;) {
        sum = 0u; cnt = 0u; mine = 0u;
#pragma unroll
        for (unsigned j = 0; j < 16; ++j) { const unsigned c = xb_ld(&bar[XB_XCNT(j)]); sum += c; cnt += (c > 0u) ? 1u : 0u; mine = (j == x) ? c : mine; }
        if (sum == G) break;
        __builtin_amdgcn_s_sleep(1);
        if ((++sp & 255u) == 0u) { if (xb_ld(&bar[XB_TMO])) break; if (sp > XB_SPIN_CAP) { atomicAdd(&bar[XB_TMO], 1u); break; } }
    }
    nloc = mine > 0u ? mine : 1u; nx = cnt > 0u ? cnt : 1u;
}

__device__ __forceinline__ void xcd_barrier(const XcdBarrier& b) {
    asm volatile("s_waitcnt vmcnt(0)" ::: "memory");
    __syncthreads();
    if (threadIdx.x == 0) {
        unsigned* bar = b.bar;
        __builtin_amdgcn_s_waitcnt(0);
        unsigned nloc = b.st[0], nx = b.st[1];
        if (nloc == 0u) { xcd_barrier_complete(bar, b.x, nloc, nx); b.st[0] = nloc; b.st[1] = nx; }
        const unsigned old = xb_add(&bar[XB_XSUB(b.x)], 1u);
        const unsigned gen = old / nloc;
        if (old + 1u == (gen + 1u) * nloc) {
            __builtin_amdgcn_fence(__ATOMIC_RELEASE, "agent");
            asm volatile("s_waitcnt vmcnt(0)" ::: "memory");
            const unsigned og = xb_add(&bar[XB_TOP], 1u);
            const unsigned tg = og / nx;
            if (og + 1u == (tg + 1u) * nx) xb_add(&bar[XB_TOPGEN], 1u);
            else XB_SPIN(xb_ld(&bar[XB_TOPGEN]) == tg, bar);
            __builtin_amdgcn_fence(__ATOMIC_ACQUIRE, "agent");
            xb_add(&bar[XB_XGEN(b.x)], 1u);
            asm volatile("s_waitcnt vmcnt(0)" ::: "memory");
        } else {
            XB_SPIN(xb_ld(&bar[XB_XGEN(b.x)]) == gen, bar);
            __builtin_amdgcn_fence(__ATOMIC_ACQUIRE, "agent");
            asm volatile("s_waitcnt vmcnt(0)" ::: "memory");
        }
    }
    __syncthreads();
}
typedef pg8::f32x4 accv;
DI unsigned ror8(unsigned v) { return (unsigned)__builtin_amdgcn_update_dpp(0, (int)v, 0x128, 0xf, 0xf, false); }
DI void store_pair(bf16* Cb, size_t ld, int rowbase, int colb, int fr, const v4u p0, const v4u p1) {
    const bool lo = fr < 8;
    v4u snd, rcv;
    snd.x = lo ? p1.x : p0.x; snd.y = lo ? p1.y : p0.y; snd.z = lo ? p1.z : p0.z; snd.w = lo ? p1.w : p0.w;
    rcv.x = ror8(snd.x); rcv.y = ror8(snd.y); rcv.z = ror8(snd.z); rcv.w = ror8(snd.w);
    v4u a, b;
    a.x = lo ? p0.x : rcv.x; a.y = lo ? p0.y : rcv.y; a.z = lo ? p0.z : rcv.z; a.w = lo ? p0.w : rcv.w;
    b.x = lo ? rcv.x : p1.x; b.y = lo ? rcv.y : p1.y; b.z = lo ? rcv.z : p1.z; b.w = lo ? rcv.w : p1.w;
    bf16* pa = Cb + (size_t)(rowbase + (fr & 7)) * ld + colb + (lo ? 0 : 32);
    *(v4u*)pa = a; *(v4u*)(pa + 8 * ld) = b;
}

struct EpiSwiGLU {
    static constexpr bool PERM = true, AFTER_DRAIN = false, CARRY = false;
    bf16* ACT;
    DI void operator()(const accv (&acc)[2][2][4][2], const pg8::Unit& u, int wr, int wc, int fr, int fq) const {
        const int row0 = u.pm * 256 + wr * 64 + fr, col0 = u.pn * 128 + wc * 32 + 8 * fq;
#pragma unroll
        for (int ai = 0; ai < 2; ++ai)
#pragma unroll
            for (int m = 0; m < 4; ++m) {
                bf16* p = ACT + (size_t)(row0 + ai * 128 + m * 16) * DFF + col0;
                const accv g0 = acc[ai][0][m][0], g1 = acc[ai][0][m][1], u0 = acc[ai][1][m][0], u1 = acc[ai][1][m][1];
                float v[8];
#pragma unroll
                for (int i = 0; i < 4; ++i) { v[i] = siluf(g0[i]) * u0[i]; v[4 + i] = siluf(g1[i]) * u1[i]; }
                *(v4u*)p = pack8(v);
            }
    }
};
struct EpiBf16Out {
    static constexpr int PERM = 2; static constexpr bool AFTER_DRAIN = false, CARRY = false;
    bf16* C; int ldc;
    DI void operator()(const accv (&acc)[2][2][4][2], const pg8::Unit& u, int wr, int wc, int fr, int fq) const {
        const int rowb = u.pm * 256 + wr * 64, colb = u.pn * 256 + wc * 64 + 8 * fq;
#pragma unroll
        for (int ai = 0; ai < 2; ++ai)
#pragma unroll
            for (int m = 0; m < 4; ++m) {
                v4u w[2];
#pragma unroll
                for (int bj = 0; bj < 2; ++bj) {
                    const accv v0 = acc[ai][bj][m][0], v1 = acc[ai][bj][m][1];
                    w[bj].x = pk2(v0[0], v0[1]); w[bj].y = pk2(v0[2], v0[3]); w[bj].z = pk2(v1[0], v1[1]); w[bj].w = pk2(v1[2], v1[3]);
                }
                store_pair(C, (size_t)ldc, rowb + ai * 128 + m * 16, colb, fr, w[0], w[1]);
            }
    }
};
struct EpiWin {
    static constexpr int PERM = 2; static constexpr bool AFTER_DRAIN = false, CARRY = false;
    bf16* SEG; bf16* GATES; float* out; int isctx; int layer;
    DI void operator()(const accv (&acc)[2][2][4][2], const pg8::Unit& u, int wr, int wc, int fr, int fq) const {
        const int pn = u.pn, row0 = u.pm * 256 + wr * 64 + fr;
        if (pn < 40) {
            const int seg = pn >> 2, col0 = (pn & 3) * 256 + wc * 64 + 8 * fq;
            bf16* base = SEG + (size_t)seg * SEGSZ;
            float* ob = nullptr;
            if (isctx) { if (seg == 1) ob = out + O_NAK; else if (seg == 2) ob = out + O_NAV; else if (seg == 8) ob = out + O_DK; else if (seg == 9) ob = out + O_DV; }
#pragma unroll
            for (int ai = 0; ai < 2; ++ai)
#pragma unroll
                for (int m = 0; m < 4; ++m) {
                    const int row = row0 + ai * 128 + m * 16;
                    v4u w[2];
#pragma unroll
                    for (int bj = 0; bj < 2; ++bj) {
                        const accv v0 = acc[ai][bj][m][0], v1 = acc[ai][bj][m][1];
                        w[bj].x = pk2(v0[0], v0[1]); w[bj].y = pk2(v0[2], v0[3]); w[bj].z = pk2(v1[0], v1[1]); w[bj].w = pk2(v1[2], v1[3]);
                        if (ob) { float* o = ob + ((size_t)((row >> 8) * 2 + layer) * 256 + (row & 255)) * 1024 + col0 + bj * 32; *(accv*)o = v0; *(accv*)(o + 4) = v1; }
                    }
                    store_pair(base, 1024, row - fr, col0, fr, w[0], w[1]);
                }
        } else {
            v4u* gp = (v4u*)GATES + ((size_t)(u.pm * 24 + (pn - 40)) * 16) * 512 + ((wr * 4 + wc) * 64 + fq * 16 + fr);
#pragma unroll
            for (int ai = 0; ai < 2; ++ai)
#pragma unroll
                for (int m = 0; m < 4; ++m) {
#pragma unroll
                    for (int bj = 0; bj < 2; ++bj) {
                        const accv v0 = acc[ai][bj][m][0], v1 = acc[ai][bj][m][1];
                        float v[8];
#pragma unroll
                        for (int i = 0; i < 4; ++i) { v[i] = sigmf(v0[i]); v[4 + i] = sigmf(v1[i]); }
                        gp[(size_t)((ai * 4 + m) * 2 + bj) * 512] = pack8(v);
                    }
                }
        }
    }
};
struct EpiBranch {
    static constexpr int PERM = 2; static constexpr bool AFTER_DRAIN = false, CARRY = false;
    const bf16* GATES; bf16* MRG; bf16* MRGB;
    DI void operator()(const accv (&acc)[2][2][4][2], const pg8::Unit& u, int wr, int wc, int fr, int fq) const {
        const int b = u.pn >> 3, pn = u.pn & 7, pm = u.pm & 31;
        const int t = (wr * 4 + wc) * 64 + fq * 16 + fr;
        const v4u* gp = (const v4u*)GATES + ((size_t)(pm * 24 + u.pn) * 16) * 512 + t;
        v4u* mp = (v4u*)MRG + ((size_t)(pm * 8 + pn) * 16) * 512 + t;
        const int row0 = pm * 256 + wr * 64 + fr, col0 = pn * 256 + wc * 64 + 8 * fq;
        v4u gq[2][2], mq[2][2];
#define BR_LOAD(slot, grp) do { \
            _Pragma("unroll") for (int p_ = 0; p_ < 2; ++p_) { gq[slot][p_] = gp[(size_t)((grp) * 2 + p_) * 512]; if (b > 0) mq[slot][p_] = mp[(size_t)((grp) * 2 + p_) * 512]; } } while (0)
        BR_LOAD(0, 0);
#pragma unroll
        for (int grp = 0; grp < 8; ++grp) {
            const int ai = grp >> 2, m = grp & 3, row = row0 + ai * 128 + m * 16, s = grp & 1;
            if (grp < 7) { if (s == 0) BR_LOAD(1, grp + 1); else BR_LOAD(0, grp + 1); }
            v4u wq[2];
#pragma unroll
            for (int bj = 0; bj < 2; ++bj) {
                float g[8]; unpack8(gq[s][bj], g);
                const accv v0 = acc[ai][bj][m][0], v1 = acc[ai][bj][m][1];
                float v[8];
#pragma unroll
                for (int i = 0; i < 4; ++i) { v[i] = v0[i] * g[i]; v[4 + i] = v1[i] * g[4 + i]; }
                if (b > 0) { float mm[8]; unpack8(mq[s][bj], mm);
#pragma unroll
                    for (int i = 0; i < 8; ++i) v[i] += mm[i]; }
                wq[bj] = pack8(v);
                if (b < 2) mp[(size_t)(grp * 2 + bj) * 512] = wq[bj];
            }
            if (b == 2) store_pair(MRGB, 2048, row - fr, col0, fr, wq[0], wq[1]);
        }
#undef BR_LOAD
    }
};
struct TrItem { const float* W; bf16* WT; int Nsrc, K, k0, src, dstrow; };
DI void tr_load(const TrItem& t, LAS float* scr, int lane) {
#pragma unroll
    for (int i = 0; i < 8; ++i) {
        const int kk = 8 * i + (lane >> 3), c4 = (lane & 7) * 4;
        f32x4 v = (f32x4){0.f, 0.f, 0.f, 0.f};
        if (t.src >= 0) v = *(const f32x4*)(t.W + (size_t)(t.k0 + kk) * t.Nsrc + t.src + c4);
        scr[kk * 33 + c4] = v[0]; scr[kk * 33 + c4 + 1] = v[1]; scr[kk * 33 + c4 + 2] = v[2]; scr[kk * 33 + c4 + 3] = v[3];
    }
}
DI void tr_store(const TrItem& t, const LAS float* scr, int lane) {
    const int c = lane & 7;
#pragma unroll
    for (int j = 0; j < 4; ++j) {
        const int n = (lane >> 3) + 8 * j; const LAS float* s = scr + (8 * c) * 33 + n;
        v4u o; o.x = pk2(s[0 * 33], s[1 * 33]); o.y = pk2(s[2 * 33], s[3 * 33]); o.z = pk2(s[4 * 33], s[5 * 33]); o.w = pk2(s[6 * 33], s[7 * 33]);
        *(v4u*)(t.WT + (size_t)(t.dstrow + n) * t.K + t.k0 + 8 * c) = o;
    }
}
DI TrItem tr_decode(KP P, int l, int it) {
    constexpr int I_GU = 32 * 352, I_DN = 88 * 64, I_IN = 32 * 520, I_BR = 16 * 64;
    bf16* WT = (bf16*)(PWS + WS_WT);
    TrItem t; int r = it;
    if (r < 2 * I_GU) {
        const int f = r / I_GU; r -= f * I_GU;
        const int kb = r / 352, nb = r % 352, j = nb >> 3, q = nb & 7, hh = q >> 2, qq = q & 3;
        t.W = (f ? PIN(15) : PIN(13)) + (size_t)l * DM * 2 * DFF; t.WT = WT + (f ? WT_GU2 : WT_GU1); t.Nsrc = 2 * DFF; t.K = DM; t.k0 = 64 * kb; t.src = hh * DFF + 128 * j + 32 * qq; t.dstrow = 32 * nb;
        return t;
    }
    r -= 2 * I_GU;
    if (r < 2 * I_DN) {
        const int f = r / I_DN; r -= f * I_DN;
        const int kb = r / 64, nb = r % 64;
        t.W = (f ? PIN(16) : PIN(14)) + (size_t)l * DFF * DM; t.WT = WT + (f ? WT_DN2 : WT_DN1); t.Nsrc = DM; t.K = DFF; t.k0 = 64 * kb; t.src = 32 * nb; t.dstrow = 32 * nb;
        return t;
    }
    r -= 2 * I_DN;
    if (r < I_IN) {
        const int kb = r / 520, nb = r % 520, n0 = 32 * nb;
        t.W = PIN(17) + (size_t)l * DM * NINR; t.WT = WT + WT_IN; t.Nsrc = NINR; t.K = DM; t.k0 = 64 * kb; t.dstrow = n0;
        t.src = n0 < 7168 ? n0 : (n0 < 16384 ? n0 + 32 : (n0 < 16416 ? 7168 + (n0 - 16384) : -1));
        return t;
    }
    r -= I_IN;
    if (r < 3 * I_BR) {
        const int b = r / I_BR; r -= b * I_BR;
        const int kb = r / 64, nb = r % 64;
        t.W = (b == 0 ? PIN(25) : (b == 1 ? PIN(26) : PIN(27))) + (size_t)l * 1024 * DM; t.WT = WT + WT_BR + (size_t)b * DM * 1024; t.Nsrc = DM; t.K = 1024; t.k0 = 64 * kb; t.src = 32 * nb; t.dstrow = 32 * nb;
        return t;
    }
    r -= 3 * I_BR;
    { const int kb = r / 64, nb = r % 64;
      t.W = PIN(28) + (size_t)l * DM * DM; t.WT = WT + WT_OUT; t.Nsrc = DM; t.K = DM; t.k0 = 64 * kb; t.src = 32 * nb; t.dstrow = 32 * nb; }
    return t;
}
DI void step_weights(KP P, const Ctx& C, int l) {
    LAS float* scr = (LAS float*)(C.L + LDS_SCR + C.wave * 17408);
    constexpr int NITEMS = 2 * 32 * 352 + 2 * 88 * 64 + 32 * 520 + 3 * 16 * 64 + 32 * 64;
    for (int it = 2 * C.gw; it < NITEMS; it += 2 * C.ngw) {
        const TrItem t0 = tr_decode(P, l, it); const bool two = it + 1 < NITEMS; const TrItem t1 = tr_decode(P, l, two ? it + 1 : it);
        tr_load(t0, scr, C.lane); if (two) tr_load(t1, scr + 64 * 33 + 64, C.lane);
        LDS_WAIT(); asm volatile("" ::: "memory");
        tr_store(t0, scr, C.lane); if (two) tr_store(t1, scr + 64 * 33 + 64, C.lane);
        LDS_WAIT(); asm volatile("" ::: "memory");
    }
}
DI void step_modpartial(KP P, const Ctx& C) {
    LAS float* sc = (LAS float*)(C.L + LDS_SCR + 140 * 1024);
    float* MODP = (float*)(PWS + WS_MODP);
    for (int task = C.bid; task < 2 * 8 * 36; task += C.G) {
        const int cc = task % 36, p = (task / 36) & 7, l = task / 288;
        __syncthreads();
        for (int e = C.tid; e < 9 * 256; e += NTHR) {
            const int s = e >> 8, k = 256 * p + (e & 255);
            const float cv = s == 0 ? PIN(8)[k] : PIN(7)[(size_t)(s - 1) * DM + k];
            sc[e] = siluf(cv);
        }
        __syncthreads();
        const int j = cc * 512 + C.tid;
        const float* W = PIN(9) + ((size_t)l * DM + 256 * p) * NMODV + j;
        float acc[9];
#pragma unroll
        for (int s = 0; s < 9; ++s) acc[s] = 0.f;
#pragma unroll 8
        for (int k = 0; k < 256; ++k) {
            const float w = W[(size_t)k * NMODV];
#pragma unroll
            for (int s = 0; s < 9; ++s) acc[s] += sc[s * 256 + k] * w;
        }
#pragma unroll
        for (int s = 0; s < 9; ++s) MODP[(((size_t)p * 2 + l) * 9 + s) * NMODV + j] = acc[s];
    }
}
DI void step_modreduce(KP P, const Ctx& C) {
    const float* MODP = (const float*)(PWS + WS_MODP); float* MOD = (float*)(PWS + WS_MOD);
    for (int e = C.bid * NTHR + C.tid; e < 2 * 9 * NMODV; e += C.G * NTHR) {
        const int l = e / (9 * NMODV), j = e % NMODV;
        float a = PIN(10)[(size_t)l * NMODV + j];
#pragma unroll
        for (int p = 0; p < 8; ++p) a += MODP[(size_t)p * 2 * 9 * NMODV + e];
        MOD[e] = a;
    }
}
DI void step_caches(KP P, const Ctx& C) {
    constexpr size_t N8 = 4194304 / 8;
    for (size_t i = (size_t)C.bid * NTHR + C.tid; i < 4 * N8; i += (size_t)C.G * NTHR) {
        const int w = (int)(i / N8); const size_t j = i % N8;
        const float* src = (w == 0 ? PIN(2) : (w == 1 ? PIN(3) : (w == 2 ? PIN(5) : PIN(6)))) + j * 8;
        bf16* dst = (bf16*)(PWS + (w == 0 ? WS_CKNA : (w == 1 ? WS_CVNA : (w == 2 ? WS_CKD : WS_CVD)))) + j * 8;
        const f32x4 a = *(const f32x4*)src, b = *(const f32x4*)(src + 4);
        v4u o; o.x = pk2(a[0], a[1]); o.y = pk2(a[2], a[3]); o.z = pk2(b[0], b[1]); o.w = pk2(b[2], b[3]);
        *(v4u*)dst = o;
    }
    if (C.bid == 0) {
        float* R = (float*)(PWS + WS_ROPE);
        for (int e = C.tid; e < 64 * 32; e += NTHR) {
            const int pos = e >> 5, i = e & 31;
            const float inv = powf(10000.0f, -(float)i / 32.0f), ang = (float)pos * inv;
            R[2 * e] = cosf(ang); R[2 * e + 1] = sinf(ang);
        }
    }
}
template <int XSRC  , int XF32  >
DI void step_rows(KP P, const Ctx& C, int l, int post, float coef, int lp, int pre) {
    float* X = POUT; bf16* XB = (bf16*)(PWS + WS_XB); const bf16* Y = (const bf16*)(PWS + WS_Y); bf16* H = (bf16*)(PWS + WS_H);
    const float* MOD = (const float*)(PWS + WS_MOD);
    const int rpb = (MTOT + C.G - 1) / C.G, r0 = C.bid * rpb, r1 = min(r0 + rpb, MTOT);
    LAS float* vw = (LAS float*)(C.L + LDS_SCR);
    const int setA = r0 < NCTX ? 0 : 1 + ((r0 - NCTX) >> 12);
    __syncthreads();
    if (r0 < r1) {
        const int setB = (r1 - 1) < NCTX ? 0 : 1 + ((r1 - 1 - NCTX) >> 12);
        for (int e = C.tid; e < 8 * 512; e += NTHR) {
            const int v = e >> 9, c4 = (e & 511) * 4;
            const float* src;
            if (v == 0) src = PIN(12) + (size_t)(l * 3 + (post < 0 ? 0 : post)) * DM;
            else if (v == 1) src = PIN(11) + (size_t)(lp * 3 + (pre < 0 ? 0 : pre)) * DM;
            else { const int s = (v - 2) / 3, k = (v - 2) % 3, st = s ? setB : setA;
                   src = k == 0 ? MOD + ((size_t)(l * 9 + st) * 9 + 3 * (post < 0 ? 0 : post) + 2) * DM : MOD + ((size_t)(lp * 9 + st) * 9 + 3 * (pre < 0 ? 0 : pre) + (k - 1)) * DM; }
            *(LAS f32x4*)(vw + v * DM + c4) = *(const f32x4*)(src + c4);
        }
    }
    __syncthreads();
    f32x4 xn[8]; v2u xbn[8]; v2u yn[8];
#define ROWS_LOAD(mm) do { const int m_ = (mm); \
        if (XSRC == 1) { const float* src = m_ < NCTX ? PIN(0) + (size_t)m_ * DM : PIN(1) + (size_t)(m_ - NCTX) * DM; \
            _Pragma("unroll") for (int j = 0; j < 8; ++j) xn[j] = *(const f32x4*)(src + 4 * C.lane + 256 * j); } \
        else { const bf16* xr = XB + (size_t)m_ * DM; \
            _Pragma("unroll") for (int j = 0; j < 8; ++j) xbn[j] = *(const v2u*)(xr + 4 * C.lane + 256 * j); } \
        if (post >= 0) { const bf16* yr = Y + (size_t)m_ * DM; \
            _Pragma("unroll") for (int j = 0; j < 8; ++j) yn[j] = *(const v2u*)(yr + 4 * C.lane + 256 * j); } } while (0)
    if (r0 + C.wave < r1) ROWS_LOAD(r0 + C.wave);
    for (int m = r0 + C.wave; m < r1; m += NWAVES) {
        const int set = m < NCTX ? 0 : 1 + ((m - NCTX) >> 12);
        const LAS float* vs = vw + 2 * DM + (set == setA ? 0 : 3 * DM);
        f32x4 xv[8]; v2u yc[8];
#pragma unroll
        for (int j = 0; j < 8; ++j) {
            if (XSRC == 1) xv[j] = xn[j];
            else { const v2u xw = xbn[j]; xv[j][0] = bf2f(xw.x & 0xffffu); xv[j][1] = bf2f(xw.x >> 16); xv[j][2] = bf2f(xw.y & 0xffffu); xv[j][3] = bf2f(xw.y >> 16); }
            yc[j] = yn[j]; }
        if (m + NWAVES < r1) ROWS_LOAD(m + NWAVES);
        if (post >= 0) {
            f32x4 yv[8]; float ss = 0.f;
#pragma unroll
            for (int j = 0; j < 8; ++j) { const v2u yw = yc[j];
                yv[j][0] = bf2f(yw.x & 0xffffu); yv[j][1] = bf2f(yw.x >> 16); yv[j][2] = bf2f(yw.y & 0xffffu); yv[j][3] = bf2f(yw.y >> 16);
                ss += (yv[j][0] * yv[j][0] + yv[j][1] * yv[j][1]) + (yv[j][2] * yv[j][2] + yv[j][3] * yv[j][3]); }
            const float r = rsqrtf(wave_sum(ss) * (1.f / DM) + EPSF) * coef;
#pragma unroll
            for (int j = 0; j < 8; ++j) {
                const f32x4 g = *(const LAS f32x4*)(vs + 4 * C.lane + 256 * j), w = *(const LAS f32x4*)(vw + 4 * C.lane + 256 * j);
                xv[j] = xv[j] + g * (yv[j] * r * w);
            }
            if (XF32) {
                float* xo = X + (size_t)m * DM;
#pragma unroll
                for (int j = 0; j < 8; ++j) *(f32x4*)(xo + 4 * C.lane + 256 * j) = xv[j];
            } else {
                bf16* xo = XB + (size_t)m * DM;
#pragma unroll
                for (int j = 0; j < 8; ++j) { v2u o; o.x = pk2(xv[j][0], xv[j][1]); o.y = pk2(xv[j][2], xv[j][3]); *(v2u*)(xo + 4 * C.lane + 256 * j) = o; }
            }
        }
        if (pre >= 0) {
            float ss = 0.f;
#pragma unroll
            for (int j = 0; j < 8; ++j) ss += (xv[j][0] * xv[j][0] + xv[j][1] * xv[j][1]) + (xv[j][2] * xv[j][2] + xv[j][3] * xv[j][3]);
            const float r = rsqrtf(wave_sum(ss) * (1.f / DM) + EPSF);
            bf16* ho = H + (size_t)m * DM;
#pragma unroll
            for (int j = 0; j < 8; ++j) {
                const f32x4 sh = *(const LAS f32x4*)(vs + DM + 4 * C.lane + 256 * j), sc = *(const LAS f32x4*)(vs + 2 * DM + 4 * C.lane + 256 * j), w = *(const LAS f32x4*)(vw + DM + 4 * C.lane + 256 * j);
                const f32x4 h = (xv[j] * r * w) * (sc + 1.f) + sh;
                v2u o; o.x = pk2(h[0], h[1]); o.y = pk2(h[2], h[3]);
                *(v2u*)(ho + 4 * C.lane + 256 * j) = o;
            }
        }
    }
#undef ROWS_LOAD
}
DI void step_prep(KP P, const Ctx& C, int l, int g) {
    const bf16* SEG = (const bf16*)(PWS + WS_SEG);
    const int T = g == 0 ? CT : LT;
    LAS float* cw = (LAS float*)(C.L + LDS_SCR);
    __syncthreads();
    for (int e = C.tid; e < 9216; e += NTHR) cw[e] = PIN(19)[(size_t)l * 9216 + e];
    __syncthreads();
    float* BL = (float*)(PWS + WS_BL);
    {
        typedef float f32x4t __attribute__((ext_vector_type(4)));
        const int r16 = C.lane & 15, quad = C.lane >> 4;
        LAS f32x4t* part = (LAS f32x4t*)(C.L + LDS_SCR + 40960);
        const bf16* Hg = (const bf16*)(PWS + WS_H) + (size_t)g * MG * DM; const bf16* Wab = (const bf16*)(PWS + WS_WT) + WT_IN + (size_t)16384 * DM;
        for (int task = C.bid; task < MG / 16; task += C.G) {
            const bf16* ap = Hg + (size_t)(16 * task + r16) * DM + 256 * C.wave + 8 * quad; const bf16* b0 = Wab + (size_t)r16 * DM + 256 * C.wave + 8 * quad; const bf16* b1 = b0 + (size_t)16 * DM;
            bf16x8 av[8], bv0[8], bv1[8];
#pragma unroll
            for (int kk = 0; kk < 8; ++kk) { av[kk] = *(const bf16x8*)(ap + 32 * kk); bv0[kk] = *(const bf16x8*)(b0 + 32 * kk); bv1[kk] = *(const bf16x8*)(b1 + 32 * kk); }
            f32x4t a0 = (f32x4t){0.f, 0.f, 0.f, 0.f}, a1 = a0;
#pragma unroll
            for (int kk = 0; kk < 8; ++kk) { a0 = __builtin_amdgcn_mfma_f32_16x16x32_bf16(av[kk], bv0[kk], a0, 0, 0, 0); a1 = __builtin_amdgcn_mfma_f32_16x16x32_bf16(av[kk], bv1[kk], a1, 0, 0, 0); }
            __syncthreads();
            part[(C.wave * 2 + 0) * 64 + C.lane] = a0; part[(C.wave * 2 + 1) * 64 + C.lane] = a1;
            __syncthreads();
            if (C.wave < 2) {
                f32x4t s = part[C.wave * 64 + C.lane];
#pragma unroll
                for (int ww = 1; ww < 8; ++ww) s = s + part[(ww * 2 + C.wave) * 64 + C.lane];
                const float alog = PIN(20)[l * 16 + r16], dtb = PIN(21)[l * 16 + r16];
#pragma unroll
                for (int j = 0; j < 4; ++j) {
                    const int row = 16 * task + 4 * quad + j;
                    if (C.wave == 0) BL[(size_t)row * 32 + r16] = sigmf(s[j]);
                    else { const float xa = s[j] + dtb, sp = fmaxf(xa, 0.f) + log1pf(__expf(-fabsf(xa))); BL[(size_t)row * 32 + 16 + r16] = -__expf(alog) * sp; }
                }
            }
        }
    }
    for (int r0 = 4 * C.gw; r0 < MG; r0 += 4 * C.ngw) {
        const int t0 = r0 & (T - 1);
        const bool hp = t0 > 0, hn = (t0 + 3) < T - 1;
        const float fp = hp ? 1.f : 0.f, fn = hn ? 1.f : 0.f;
        const int rp = hp ? r0 - 1 : r0, rn = hn ? r0 + 4 : r0 + 3;
        v4u rawA[6][2], rawB[6][2];
#define PREP_LOADSEG(RAW, w_) do { const bf16* sb_ = SEG + (size_t)(3 + (w_)) * SEGSZ + 8 * C.lane; \
            _Pragma("unroll") for (int k = 0; k < 6; ++k) { const int rk = k == 0 ? rp : (k == 5 ? rn : r0 + k - 1); \
                _Pragma("unroll") for (int hf = 0; hf < 2; ++hf) RAW[k][hf] = *(const v4u*)(sb_ + (size_t)rk * 1024 + 512 * hf); } } while (0)
#define PREP_COMPUTE(RAW, w_) do { constexpr int w = (w_); bf16* dstb = (bf16*)(PWS + (w == 0 ? WS_QN : (w == 1 ? WS_KN : WS_VN))) + 8 * C.lane; \
            _Pragma("unroll") for (int r = 0; r < 4; ++r) { const float mp = r == 0 ? fp : 1.f, mn = r == 3 ? fn : 1.f; \
                _Pragma("unroll") for (int hf = 0; hf < 2; ++hf) { \
                    float xp[8], xc[8], xn[8], y[8]; unpack8(RAW[r][hf], xp); unpack8(RAW[r + 1][hf], xc); unpack8(RAW[r + 2][hf], xn); \
                    const int ch = w * 1024 + 512 * hf + 8 * C.lane; float c0[8], c1[8], c2[8]; \
                    _Pragma("unroll") for (int q = 0; q < 2; ++q) { const f32x4 a0 = *(const LAS f32x4*)(cw + ch + 4 * q), a1 = *(const LAS f32x4*)(cw + 3072 + ch + 4 * q), a2 = *(const LAS f32x4*)(cw + 6144 + ch + 4 * q); \
                        _Pragma("unroll") for (int i = 0; i < 4; ++i) { c0[4 * q + i] = a0[i]; c1[4 * q + i] = a1[i]; c2[4 * q + i] = a2[i]; } } \
                    float ss = 0.f; \
                    _Pragma("unroll") for (int i = 0; i < 8; ++i) { const float cv = (mp * xp[i]) * c0[i] + xc[i] * c1[i] + (mn * xn[i]) * c2[i]; y[i] = siluf(cv); ss += y[i] * y[i]; } \
                    if (w < 2) { ss += __shfl_xor(ss, 1); ss += __shfl_xor(ss, 2); ss += __shfl_xor(ss, 4); ss += __shfl_xor(ss, 8); \
                        const float rr = rsqrtf(ss + EPSF) * (w == 0 ? QSCALE : 1.f); \
                        _Pragma("unroll") for (int i = 0; i < 8; ++i) y[i] *= rr; } \
                    *(v4u*)(dstb + (size_t)(r0 + r) * 1024 + 512 * hf) = pack8(y); } } } while (0)
        PREP_LOADSEG(rawA, 0); PREP_LOADSEG(rawB, 1); __builtin_amdgcn_sched_barrier(0);
        PREP_COMPUTE(rawA, 0); __builtin_amdgcn_sched_barrier(0);
        PREP_LOADSEG(rawA, 2); __builtin_amdgcn_sched_barrier(0);
        PREP_COMPUTE(rawB, 1); __builtin_amdgcn_sched_barrier(0);
        PREP_COMPUTE(rawA, 2); __builtin_amdgcn_sched_barrier(0);
        v4u own[4][2][2];
        if (g > 0) {
#pragma unroll
            for (int r = 0; r < 4; ++r)
#pragma unroll
                for (int w = 0; w < 2; ++w)
#pragma unroll
                    for (int hf = 0; hf < 2; ++hf) own[r][w][hf] = *(const v4u*)((const bf16*)(PWS + WS_SEG) + (size_t)(7 + w) * SEGSZ + (size_t)(r0 + r) * 1024 + 512 * hf + 8 * C.lane);
        }
#undef PREP_LOADSEG
#undef PREP_COMPUTE
        if (g > 0) {
            const float* R = (const float*)(PWS + WS_ROPE);
            const int a = (C.lane >> 3) & 1, i0 = 8 * (C.lane & 3);
            const float sgn = ((C.lane >> 2) & 1) ? 1.f : -1.f;
#pragma unroll
            for (int r = 0; r < 4; ++r) {
                const int t = t0 + r, pos = a == 0 ? (t >> 6) : (t & 63);
                float cs[8], sn[8];
#pragma unroll
                for (int k = 0; k < 4; ++k) { const f32x4 v = *(const f32x4*)(R + (size_t)(pos * 32 + i0 + 2 * k) * 2); cs[2 * k] = v[0]; sn[2 * k] = v[1]; cs[2 * k + 1] = v[2]; sn[2 * k + 1] = v[3]; }
#pragma unroll
                for (int w = 0; w < 2; ++w) {
#pragma unroll
                    for (int hf = 0; hf < 2; ++hf) {
                        const size_t off = (size_t)(r0 + r) * 1024 + 512 * hf + 8 * C.lane;
                        const v4u ow = own[r][w][hf];
                        v4u oth; oth.x = __shfl_xor(ow.x, 4); oth.y = __shfl_xor(ow.y, 4); oth.z = __shfl_xor(ow.z, 4); oth.w = __shfl_xor(ow.w, 4);
                        float xo[8], xt[8], y[8]; unpack8(ow, xo); unpack8(oth, xt);
#pragma unroll
                        for (int i = 0; i < 8; ++i) y[i] = xo[i] * cs[i] + sgn * (xt[i] * sn[i]);
                        *(v4u*)((bf16*)(PWS + (w == 0 ? WS_DQR : WS_DKR)) + off) = pack8(y);
                    }
                }
            }
        }
    }
}
DI void step_post(KP P, const Ctx& C, int l) {
    const bf16* OGF = (const bf16*)(PWS + WS_OGF); const bf16* OGB = (const bf16*)(PWS + WS_OGB);
    const bf16* GZ = (const bf16*)(PWS + WS_SEG) + (size_t)6 * SEGSZ; const bf16* DOb = (const bf16*)(PWS + WS_DO);
    bf16* OG = (bf16*)(PWS + WS_OG); bf16* OD = (bf16*)(PWS + WS_OD);
    float lam, lam_init;
    {
        const float* L4 = PIN(23) + (size_t)l * 512;
        const float a = L4[C.lane] * L4[128 + C.lane] + L4[64 + C.lane] * L4[128 + 64 + C.lane];
        const float b = L4[256 + C.lane] * L4[384 + C.lane] + L4[256 + 64 + C.lane] * L4[384 + 64 + C.lane];
        lam_init = 0.8f - 0.6f * expf(-0.3f * (float)l);
        lam = expf(wave_sum(a)) - expf(wave_sum(b)) + lam_init;
    }
    const int c4 = 4 * C.lane;
    float gw_[4], dw_[4];
#pragma unroll
    for (int i = 0; i < 4; ++i) { gw_[i] = PIN(22)[(size_t)l * 128 + ((c4 + i) & 127)]; dw_[i] = PIN(24)[(size_t)l * 256 + c4 + i] * (1.f - lam_init); }
    v2u ofn[4], obn[4]; v2u gzn[4], d0n[4], d1n[4];
#define POST_LOAD(rr) do { const size_t r_ = (size_t)(rr); \
        _Pragma("unroll") for (int q = 0; q < 4; ++q) { \
            ofn[q] = *(const v2u*)(OGF + r_ * 1024 + 256 * q + c4); obn[q] = *(const v2u*)(OGB + r_ * 1024 + 256 * q + c4); \
            gzn[q] = *(const v2u*)(GZ + r_ * 1024 + 256 * q + c4); \
            d0n[q] = *(const v2u*)(DOb + r_ * 2048 + 512 * q + c4); d1n[q] = *(const v2u*)(DOb + r_ * 2048 + 512 * q + 256 + c4); } } while (0)
    if (C.gw < MG) POST_LOAD(C.gw);
    for (int row = C.gw; row < MG; row += C.ngw) {
        v2u of[4], ob[4]; v2u gz[4], d0[4], d1[4];
#pragma unroll
        for (int q = 0; q < 4; ++q) { of[q] = ofn[q]; ob[q] = obn[q]; gz[q] = gzn[q]; d0[q] = d0n[q]; d1[q] = d1n[q]; }
        POST_LOAD(row + C.ngw < MG ? row + C.ngw : row);
#pragma unroll
        for (int q = 0; q < 4; ++q) {
            f32x4 o; { const v2u a_ = of[q], b_ = ob[q]; o[0] = bf2f(a_.x & 0xffffu) + bf2f(b_.x & 0xffffu); o[1] = bf2f(a_.x >> 16) + bf2f(b_.x >> 16); o[2] = bf2f(a_.y & 0xffffu) + bf2f(b_.y & 0xffffu); o[3] = bf2f(a_.y >> 16) + bf2f(b_.y >> 16); }
            float ss = (o[0] * o[0] + o[1] * o[1]) + (o[2] * o[2] + o[3] * o[3]);
            ss += __shfl_xor(ss, 1); ss += __shfl_xor(ss, 2); ss += __shfl_xor(ss, 4); ss += __shfl_xor(ss, 8); ss += __shfl_xor(ss, 16);
            const float r = rsqrtf(ss * (1.f / 128.f) + EPSF);
            const v2u zw = gz[q];
            const float z0 = bf2f(zw.x & 0xffffu), z1 = bf2f(zw.x >> 16), z2 = bf2f(zw.y & 0xffffu), z3 = bf2f(zw.y >> 16);
            v2u w; w.x = pk2(o[0] * r * gw_[0] * siluf(z0), o[1] * r * gw_[1] * siluf(z1)); w.y = pk2(o[2] * r * gw_[2] * siluf(z2), o[3] * r * gw_[3] * siluf(z3));
            *(v2u*)(OG + (size_t)row * 1024 + 256 * q + c4) = w;
        }
#pragma unroll
        for (int q = 0; q < 4; ++q) {
            const v2u aw = d0[q], bw = d1[q];
            float o[4];
            o[0] = bf2f(aw.x & 0xffffu) - lam * bf2f(bw.x & 0xffffu); o[1] = bf2f(aw.x >> 16) - lam * bf2f(bw.x >> 16);
            o[2] = bf2f(aw.y & 0xffffu) - lam * bf2f(bw.y & 0xffffu); o[3] = bf2f(aw.y >> 16) - lam * bf2f(bw.y >> 16);
            const float ss = wave_sum((o[0] * o[0] + o[1] * o[1]) + (o[2] * o[2] + o[3] * o[3]));
            const float r = rsqrtf(ss * (1.f / 256.f) + EPSF);
            v2u w; w.x = pk2(o[0] * r * dw_[0], o[1] * r * dw_[1]); w.y = pk2(o[2] * r * dw_[2], o[3] * r * dw_[3]);
            *(v2u*)(OD + (size_t)row * 1024 + 256 * q + c4) = w;
        }
    }
#undef POST_LOAD
}
namespace at2 {
using f32x16 = __attribute__((ext_vector_type(16))) float;
using s16x4  = __attribute__((ext_vector_type(4))) short;
using u32x4  = __attribute__((ext_vector_type(4))) unsigned;
constexpr int D = 128, NW = 8, QBLK = 32, KVBLK = 64, LDX = 1024;
constexpr float SCALE = 0.088388347648318440f, THR = 8.f, INV_SCALE = 11.313708498984761f;

constexpr size_t SHM_V = KVBLK * D * 2, SHM_K = KVBLK * D * 2, SHM_ATTN = 2 * SHM_V + 2 * SHM_K + NW * 64 * 4;
#define KSWZ(row, colB) ((row) * 256 + ((colB) ^ (((row) & 7) << 4)))
#define SBAR() __builtin_amdgcn_sched_barrier(0)
DI int crow(int r, int hi) { return (r & 3) + 8 * (r >> 2) + 4 * hi; }
DI unsigned cvtpk(float lo, float hi) { unsigned r; asm volatile("v_cvt_pk_bf16_f32 %0, %1, %2" : "=v"(r) : "v"(lo), "v"(hi)); return r; }

struct NaMask { int on, r0, kr_lo; const LAS float* bias; };

DI void partialSM(f32x16& p0, f32x16& p1, float& m_reg, float& mn, float& alpha) {
  constexpr float C = SCALE * 1.4426950408889634f;
  float pmax = p0[0];
#pragma unroll
  for (int r = 1; r < 16; ++r) pmax = fmaxf(pmax, p0[r]);
#pragma unroll
  for (int r = 0; r < 16; ++r) pmax = fmaxf(pmax, p1[r]);
  { auto rr = __builtin_amdgcn_permlane32_swap(__float_as_uint(pmax), __float_as_uint(pmax), false, false);
    pmax = fmaxf(__uint_as_float(rr[0]), __uint_as_float(rr[1])); }
  if (__builtin_expect(__all(pmax - m_reg <= THR / SCALE), 1)) { mn = m_reg; alpha = 1.f; }
  else { mn = fmaxf(m_reg, pmax); alpha = __builtin_amdgcn_exp2f((m_reg - mn) * C); m_reg = mn; }
  float mnC = -mn * C;
#pragma unroll
  for (int r = 0; r < 16; ++r) p0[r] = fmaf(p0[r], C, mnC);
#pragma unroll
  for (int r = 0; r < 16; ++r) p1[r] = fmaf(p1[r], C, mnC);
#pragma unroll
  for (int r = 0; r < 16; ++r) p0[r] = __builtin_amdgcn_exp2f(p0[r]);
}
DI void finishSM(f32x16& p0, f32x16& p1, float alpha, float& l_reg, bf16x8& pa0, bf16x8& pa1, bf16x8& pa2, bf16x8& pa3) {
#pragma unroll
  for (int r = 0; r < 16; ++r) p1[r] = __builtin_amdgcn_exp2f(p1[r]);
  float ps = 0;
#pragma unroll
  for (int r = 0; r < 16; ++r) ps += p0[r];
#pragma unroll
  for (int r = 0; r < 16; ++r) ps += p1[r];
  { auto rr = __builtin_amdgcn_permlane32_swap(__float_as_uint(ps), __float_as_uint(ps), false, false);
    ps = __uint_as_float(rr[0]) + __uint_as_float(rr[1]); }
  l_reg = l_reg * alpha + ps;
#define PK4(P, BASE, OUT) do { unsigned a0 = cvtpk(P[BASE + 0], P[BASE + 1]), a1 = cvtpk(P[BASE + 2], P[BASE + 3]);   \
    unsigned b0 = cvtpk(P[BASE + 4], P[BASE + 5]), b1 = cvtpk(P[BASE + 6], P[BASE + 7]);                              \
    auto r0 = __builtin_amdgcn_permlane32_swap(a0, b0, false, false); auto r1 = __builtin_amdgcn_permlane32_swap(a1, b1, false, false); \
    u32x4 w = {r0[0], r1[0], r0[1], r1[1]}; OUT = *reinterpret_cast<bf16x8*>(&w); } while (0)
  PK4(p0, 0, pa0); PK4(p0, 8, pa1); PK4(p1, 0, pa2); PK4(p1, 8, pa3);
#undef PK4
}
template <bool QLDS> DI void qkt(f32x16& p0, f32x16& p1, const bf16* Ks, const bf16x8* qr, const char* qlds, int r32, int hi) {
  p0 = f32x16{}; p1 = f32x16{};
#pragma unroll
  for (int d0 = 0; d0 < 8; ++d0) { int cb = (d0 * 16 + hi * 8) * 2;
    bf16x8 qv; if constexpr (QLDS) qv = *reinterpret_cast<const bf16x8*>(qlds + d0 * 1024); else qv = qr[d0];
    bf16x8 b0 = *reinterpret_cast<const bf16x8*>((const char*)Ks + KSWZ(r32, cb));
    bf16x8 b1 = *reinterpret_cast<const bf16x8*>((const char*)Ks + KSWZ(32 + r32, cb));
    p0 = __builtin_amdgcn_mfma_f32_32x32x16_bf16(b0, qv, p0, 0, 0, 0);
    p1 = __builtin_amdgcn_mfma_f32_32x32x16_bf16(b1, qv, p1, 0, 0, 0); }
}
DI void na_mask(f32x16& p0, f32x16& p1, int jt, int wid, int r32, int hi, const NaMask& mk) {
  if (jt < 4) return;
  const int kr = mk.kr_lo + (jt - 4), r = mk.r0 + (wid >> 1), c = (wid & 1) * 32 + r32;
  const int rs = min(max(r - 4, 0), 56), cs = min(max(c - 8, 0), 48);
  const bool rv = (kr >= rs) && (kr < rs + 8);
  const int dr = rv ? (kr - r + 7) : 0;
  const LAS float* brow = mk.bias + dr * 31 + (15 - c);
#pragma unroll
  for (int i = 0; i < 16; ++i) {
    const int kc0 = crow(i, hi), kc1 = kc0 + 32;
    const bool ok0 = rv && ((unsigned)(kc0 - cs) < 16u), ok1 = rv && ((unsigned)(kc1 - cs) < 16u);
    const float b0 = brow[ok0 ? kc0 : c], b1 = brow[ok1 ? kc1 : c];
    p0[i] = ok0 ? fmaf(b0, INV_SCALE, p0[i]) : -1e30f;
    p1[i] = ok1 ? fmaf(b1, INV_SCALE, p1[i]) : -1e30f;
  }
}
DI int v_st(int k, int c) { const int kk = (k & ~0xC) | ((k & 4) << 1) | ((k & 8) >> 1); return ((kk >> 3) * 4 + (c >> 5)) * 512 + ((kk & 7) * 32 + (c & 31)) * 2; }
DI int v_rd_base(int lane) { return ((lane & 3) << 3) | (((lane >> 2) & 3) << 6) | (((lane >> 4) & 1) << 5) | (((lane >> 5) & 1) << 8); }
constexpr int v_rd_off(int d0, int ks, int half) { return d0 * 512 + ks * 4096 + half * 2048; }
template <int OFF> DI s16x4 tr_read(int vb) {
  s16x4 r; asm volatile("ds_read_b64_tr_b16 %0, %1 offset:%2" : "=&v"(r) : "v"(vb), "i"(OFF) : "memory"); return r;
}
template <int D0> DI void pv_one(f32x16& od, int vb, bf16x8 pa0, bf16x8 pa1, bf16x8 pa2, bf16x8 pa3) {
  const s16x4 l0 = tr_read<v_rd_off(D0, 0, 0)>(vb), h0 = tr_read<v_rd_off(D0, 0, 1)>(vb), l1 = tr_read<v_rd_off(D0, 1, 0)>(vb), h1 = tr_read<v_rd_off(D0, 1, 1)>(vb);
  const s16x4 l2 = tr_read<v_rd_off(D0, 2, 0)>(vb), h2 = tr_read<v_rd_off(D0, 2, 1)>(vb), l3 = tr_read<v_rd_off(D0, 3, 0)>(vb), h3 = tr_read<v_rd_off(D0, 3, 1)>(vb);
  asm volatile("s_waitcnt lgkmcnt(0)" ::: "memory"); SBAR();
#define PK(L, H) (bf16x8){L[0], L[1], L[2], L[3], H[0], H[1], H[2], H[3]}
  od = __builtin_amdgcn_mfma_f32_32x32x16_bf16(pa0, PK(l0, h0), od, 0, 0, 0);
  od = __builtin_amdgcn_mfma_f32_32x32x16_bf16(pa1, PK(l1, h1), od, 0, 0, 0);
  od = __builtin_amdgcn_mfma_f32_32x32x16_bf16(pa2, PK(l2, h2), od, 0, 0, 0);
  od = __builtin_amdgcn_mfma_f32_32x32x16_bf16(pa3, PK(l3, h3), od, 0, 0, 0);
#undef PK
}
DI void pv_d0(f32x16* o, int vb, bf16x8 pa0, bf16x8 pa1, bf16x8 pa2, bf16x8 pa3) {
  pv_one<0>(o[0], vb, pa0, pa1, pa2, pa3); pv_one<1>(o[1], vb, pa0, pa1, pa2, pa3); pv_one<2>(o[2], vb, pa0, pa1, pa2, pa3); pv_one<3>(o[3], vb, pa0, pa1, pa2, pa3);
}

template <bool MASKED, int SDEPTH> DI void attn_body(const bf16* __restrict__ Qb, const bf16* __restrict__ K1, const bf16* __restrict__ V1, int n1,
                  const bf16* __restrict__ K2, const bf16* __restrict__ V2, int n2, bf16* __restrict__ Ob, int ldo, char* lds, const NaMask mk) {
  int tid_l = threadIdx.x; asm volatile("" : "+v"(tid_l));
  const int tid = tid_l, wid = tid >> 6, lane = tid & 63, r32 = lane & 31, hi = lane >> 5;
  bf16* V_lds = (bf16*)lds; bf16* K_lds = (bf16*)(lds + 2 * SHM_V);
  float* ws = (float*)(lds + 2 * SHM_V + 2 * SHM_K) + wid * 64; float* li_l = ws; float* al_l = ws + 32;
  float m_reg = -1e30f, l_reg = 0; f32x16 o[4] = {}; bf16x8 qr[8];
  const bf16* Qw = Qb + (long)(wid * QBLK + r32) * LDX + hi * 8;
  char* qlds = lds + SHM_ATTN + 2048 + wid * 8192 + lane * 16;
#pragma unroll
  for (int d0 = 0; d0 < 8; ++d0) { const bf16x8 qv = *reinterpret_cast<const bf16x8*>(Qw + d0 * 16); if constexpr (MASKED) *reinterpret_cast<bf16x8*>(qlds + d0 * 1024) = qv; else qr[d0] = qv; }
  const int sr = tid >> 4, sc = (tid & 15) * 8, vst0 = v_st(sr, sc), vst1 = v_st(32 + sr, sc);
  const int vb0 = (int)(uintptr_t)V_lds + v_rd_base(lane);
  const unsigned toff = (unsigned)(sr * LDX + sc) * 2u;
  struct { bf16x8 vs0, vs1, ks0, ks1; } sr_[SDEPTH];
#define SLOAD(i, k0) do { const int _k = (k0); const char* _kp = (const char*)(_k < n1 ? K1 + (long)_k * LDX : K2 + (long)(_k - n1) * LDX); const char* _vp = (const char*)(_k < n1 ? V1 + (long)_k * LDX : V2 + (long)(_k - n1) * LDX); \
    sr_[i].vs0 = *reinterpret_cast<const bf16x8*>(_vp + toff); sr_[i].vs1 = *reinterpret_cast<const bf16x8*>(_vp + 65536 + toff); \
    sr_[i].ks0 = *reinterpret_cast<const bf16x8*>(_kp + toff); sr_[i].ks1 = *reinterpret_cast<const bf16x8*>(_kp + 65536 + toff); } while (0)
#define SWRITE(b, i) do { *(bf16x8*)((char*)V_lds + (b) * SHM_V + vst0) = sr_[i].vs0;          \
    *(bf16x8*)((char*)V_lds + (b) * SHM_V + vst1) = sr_[i].vs1; int kc = sc * 2;               \
    *(bf16x8*)((char*)K_lds + (b) * SHM_K + KSWZ(sr, kc)) = sr_[i].ks0;                       \
    *(bf16x8*)((char*)K_lds + (b) * SHM_K + KSWZ(32 + sr, kc)) = sr_[i].ks1; } while (0)
#define SWAIT() do { if constexpr (SDEPTH == 2) asm volatile("s_waitcnt vmcnt(4)" ::: "memory"); else asm volatile("s_waitcnt vmcnt(0)" ::: "memory"); } while (0)
#define RESC(a) do { if (__any((a) < 1.f)) { if (hi == 0) al_l[r32] = (a); asm volatile("s_waitcnt lgkmcnt(0)" ::: "memory"); \
    _Pragma("unroll") for (int d = 0; d < 4; ++d) _Pragma("unroll") for (int r = 0; r < 16; ++r) o[d][r] *= al_l[crow(r, hi)]; } } while (0)
#define MASK(P0, P1, JT) do { if constexpr (MASKED) na_mask(P0, P1, (JT), wid, r32, hi, mk); } while (0)
  f32x16 pA0, pA1, pB0, pB1; float mnA, mnB, alA, alB; bf16x8 pa0, pa1, pa2, pa3; const int NT = (n1 + n2) / KVBLK;
  constexpr int SE = 0, SO = SDEPTH - 1;
  SLOAD(SE, 0); asm volatile("s_waitcnt vmcnt(0)" ::: "memory"); SWRITE(0, SE); __syncthreads();
  qkt<MASKED>(pA0, pA1, K_lds, qr, qlds, r32, hi); MASK(pA0, pA1, 0); partialSM(pA0, pA1, m_reg, mnA, alA);
  SLOAD(SO, KVBLK); if constexpr (SDEPTH == 2) { if (2 < NT) SLOAD(SE, 2 * KVBLK); }
  SWAIT(); SWRITE(1, SO); __syncthreads();
  for (int j = 1; j + 1 < NT; j += 2) {
    SBAR(); qkt<MASKED>(pB0, pB1, (bf16*)((char*)K_lds + SHM_K), qr, qlds, r32, hi); MASK(pB0, pB1, j);
    finishSM(pA0, pA1, alA, l_reg, pa0, pa1, pa2, pa3); SBAR();
    SLOAD(SO, (j + SDEPTH) * KVBLK); SBAR();
    pv_d0(o, vb0, pa0, pa1, pa2, pa3); partialSM(pB0, pB1, m_reg, mnB, alB);
    __syncthreads(); SWAIT(); SWRITE(0, SE);
    RESC(alB); __syncthreads();
    SBAR(); qkt<MASKED>(pA0, pA1, K_lds, qr, qlds, r32, hi); MASK(pA0, pA1, j + 1);
    finishSM(pB0, pB1, alB, l_reg, pa0, pa1, pa2, pa3); SBAR();
    if (SDEPTH == 1 || j + 3 < NT) SLOAD(SE, (j + 1 + SDEPTH) * KVBLK); SBAR();
    pv_d0(o, vb0 + (int)SHM_V, pa0, pa1, pa2, pa3); partialSM(pA0, pA1, m_reg, mnA, alA);
    __syncthreads(); SWAIT(); SWRITE(1, SO);
    RESC(alA); __syncthreads();
  }
  SBAR(); qkt<MASKED>(pB0, pB1, (bf16*)((char*)K_lds + SHM_K), qr, qlds, r32, hi); MASK(pB0, pB1, NT - 1);
  finishSM(pA0, pA1, alA, l_reg, pa0, pa1, pa2, pa3); SBAR();
  pv_d0(o, vb0, pa0, pa1, pa2, pa3); partialSM(pB0, pB1, m_reg, mnB, alB);
  __syncthreads(); RESC(alB);
  finishSM(pB0, pB1, alB, l_reg, pa0, pa1, pa2, pa3); SBAR();
  pv_d0(o, vb0 + (int)SHM_V, pa0, pa1, pa2, pa3);
  if (hi == 0) li_l[r32] = l_reg; asm volatile("s_waitcnt lgkmcnt(0)" ::: "memory");
  float rli[16];
#pragma unroll
  for (int r = 0; r < 16; ++r) rli[r] = __builtin_amdgcn_rcpf(li_l[crow(r, hi)]);
  bf16* Ow = Ob + (long)(wid * QBLK) * ldo;
#pragma unroll
  for (int r = 0; r < 16; ++r) { const int orow = crow(r, hi);
#pragma unroll
    for (int d0 = 0; d0 < 4; ++d0) Ow[(long)orow * ldo + d0 * 32 + r32] = (bf16)f2bf(o[d0][r] * rli[r]); }
#undef SLOAD
#undef SWRITE
#undef SWAIT
#undef RESC
#undef MASK
}
}
typedef float f32x4g __attribute__((ext_vector_type(4)));
DI int gdn_tok(int cg, int i, int dir, int T) {
    const int lc = T == 256 ? 2 : 6, seq = cg >> lc, c = cg & ((1 << lc) - 1);
    return dir ? seq * T + T - 1 - (64 * c + i) : cg * 64 + i;
}
#define CHK_BAR() asm volatile("s_waitcnt lgkmcnt(0)\n\ts_barrier" ::: "memory")
DI void gdn_chunk_loop(KP P, const Ctx& C, int first, int nitems, int stride, int T) {
    constexpr int XS = 272;
    LAS float* X = (LAS float*)(C.L + LDS_SCR);
    LAS float* At = X + 64 * XS;
    LAS float* kf = At + 64 * 64;
    LAS float* gm = kf + 64 * 129;
    LAS bf16* Kb = (LAS bf16*)(gm + 192);
    asm volatile("" : "+v"(X), "+v"(At), "+v"(kf), "+v"(gm), "+v"(Kb));
    const bf16* QN = (const bf16*)(PWS + WS_QN); const bf16* KN = (const bf16*)(PWS + WS_KN); const bf16* VN = (const bf16*)(PWS + WS_VN);
    const float* BL = (const float*)(PWS + WS_BL);
    const int lane = C.lane, r16 = lane & 15, quad = lane >> 4, w = C.wave, sel = w >> 2, rb = w & 3;
    bf16x8 af[4]; v4u kv[4]; float la_r = 0.f, be_r = 0.f;
#define CHK_LOAD(itx) do { const int it_ = (itx), dir_ = it_ & 1, h_ = (it_ >> 1) & 7, cg_ = it_ >> 4; \
        { const size_t ta = (size_t)gdn_tok(cg_, 16 * rb + r16, dir_, T); const bf16* ap = (sel ? QN : KN) + ta * 1024 + h_ * 128 + 8 * quad; \
          _Pragma("unroll") for (int kk = 0; kk < 4; ++kk) af[kk] = *(const bf16x8*)(ap + 32 * kk); } \
        _Pragma("unroll") for (int q = 0; q < 4; ++q) { const int e = C.tid + q * NTHR, ww = e >> 10, i = (e >> 4) & 63, c8 = (e & 15) * 8; \
          const size_t tok = (size_t)gdn_tok(cg_, i, dir_, T); kv[q] = *(const v4u*)((ww == 0 ? KN : VN) + tok * 1024 + h_ * 128 + c8); } \
        if (w == 0) { const size_t tok = (size_t)gdn_tok(cg_, lane, dir_, T); la_r = BL[tok * 32 + 16 + dir_ * 8 + h_]; be_r = BL[tok * 32 + dir_ * 8 + h_]; } } while (0)
    if (first < nitems) CHK_LOAD(first);
    for (int item = first; item < nitems; item += stride) {
        const int dir = item & 1, h = (item >> 1) & 7, cg = item >> 4;
        CHK_BAR();
        if (w == 0) {
            float la = la_r;
#pragma unroll
            for (int o = 1; o < 64; o <<= 1) { const float t = __shfl_up(la, o); if (lane >= o) la += t; }
            gm[lane] = la; gm[64 + lane] = be_r; gm[128 + lane] = __expf(la);
            ((float*)(PWS + WS_GAM))[(((size_t)dir * 128 + cg) * 8 + h) * 64 + lane] = la;
        }
#pragma unroll
        for (int q = 0; q < 2; ++q) { const int e = C.tid + q * NTHR, i = (e >> 4) & 63, c8 = (e & 15) * 8; *(LAS v4u*)(Kb + i * 136 + c8) = kv[q]; }
        CHK_BAR();
        f32x4g acc[4];
        {
            bf16x8 bfr[4][4];
#pragma unroll
            for (int cb = 0; cb < 4; ++cb)
#pragma unroll
                for (int kk = 0; kk < 4; ++kk) bfr[cb][kk] = *(const LAS bf16x8*)(Kb + (16 * cb + r16) * 136 + 32 * kk + 8 * quad);
            asm volatile("s_waitcnt lgkmcnt(0)" ::: "memory"); __builtin_amdgcn_sched_barrier(0);
#pragma unroll
            for (int cb = 0; cb < 4; ++cb) {
                acc[cb] = (f32x4g){0.f, 0.f, 0.f, 0.f};
#pragma unroll
                for (int kk = 0; kk < 4; ++kk) acc[cb] = __builtin_amdgcn_mfma_f32_16x16x32_bf16(af[kk], bfr[cb][kk], acc[cb], 0, 0, 0);
            }
            if (sel) {
                bf16* qc = (bf16*)(PWS + WS_QC) + (((size_t)dir * 128 + cg) * 8 + h) * 8192 + (size_t)(rb * 256 + lane) * 8;
#pragma unroll
                for (int kk = 0; kk < 4; ++kk) *(bf16x8*)(qc + kk * 512) = af[kk];
            }
        }
#pragma unroll
        for (int q = 0; q < 4; ++q) {
            const int e = C.tid + q * NTHR, ww = e >> 10, i = (e >> 4) & 63, c8 = (e & 15) * 8;
            float f[8]; unpack8(kv[q], f);
            const float be = gm[64 + i];
            if (ww == 0) {
                const float s = be * gm[128 + i];
#pragma unroll
                for (int x = 0; x < 8; ++x) { kf[i * 129 + c8 + x] = f[x]; X[i * XS + 128 + c8 + x] = s * f[x]; }
            } else {
#pragma unroll
                for (int x = 0; x < 8; ++x) X[i * XS + c8 + x] = be * f[x];
            }
        }
        {
            bf16* Pg = (bf16*)(PWS + WS_P) + (((size_t)dir * 128 + cg) * 8 + h) * 4096;
#pragma unroll
            for (int cb = 0; cb < 4; ++cb)
#pragma unroll
                for (int j = 0; j < 4; ++j) {
                    const int i = 16 * rb + 4 * quad + j, jc = 16 * cb + r16;
                    const float dec = (jc <= i) ? __expf(gm[i] - gm[jc]) : 0.f;
                    if (sel == 0) At[jc * 64 + i] = (jc < i) ? gm[64 + i] * acc[cb][j] * dec : 0.f;
                    else Pg[((rb * 2 + (cb >> 1)) * 64 + (2 * (cb & 1) + (r16 >> 3)) * 16 + 4 * quad + j) * 8 + (r16 & 7)] = (bf16)f2bf(acc[cb][j] * dec);
                }
        }
        if (item + stride < nitems) CHK_LOAD(item + stride);
        CHK_BAR();
        {
            const int d = C.tid >> 2, i0 = (C.tid & 3) * 16;
            const float gl = gm[63];
            bf16* dst = (bf16*)(PWS + WS_KDT) + (((size_t)dir * 128 + cg) * 8 + h) * 8192; (void)i0;
#pragma unroll
            for (int q = 0; q < 2; ++q) {
                float f[8];
#pragma unroll
                for (int x = 0; x < 8; ++x) { const int i = i0 + 8 * q + x; f[x] = kf[i * 129 + d] * __expf(gl - gm[i]); }
                { const int p = (C.tid & 3) * 2 + q; *(v4u*)(dst + (size_t)((((d >> 4) * 2 + (p >> 2)) * 64 + (p & 3) * 16 + (d & 15)) * 8)) = pack8(f); }
            }
        }
#pragma unroll
        for (int b = 0; b < 4; ++b) {
            if (b > 0) {
                float av[12], bv0[12], bv1[12]; f32x4g r0, r1;
#pragma unroll
                for (int c = 0; c < b; ++c)
#pragma unroll
                    for (int ks = 0; ks < 4; ++ks) {
                        const int kr = 16 * c + 4 * ks + quad;
                        av[4 * c + ks] = -At[kr * 64 + 16 * b + r16]; bv0[4 * c + ks] = X[kr * XS + 32 * w + r16]; bv1[4 * c + ks] = X[kr * XS + 32 * w + 16 + r16];
                    }
#pragma unroll
                for (int j = 0; j < 4; ++j) { r0[j] = X[(16 * b + 4 * quad + j) * XS + 32 * w + r16]; r1[j] = X[(16 * b + 4 * quad + j) * XS + 32 * w + 16 + r16]; }
                asm volatile("s_waitcnt lgkmcnt(0)" ::: "memory"); __builtin_amdgcn_sched_barrier(0);
#pragma unroll
                for (int q = 0; q < 4 * b; ++q) { r0 = __builtin_amdgcn_mfma_f32_16x16x4f32(av[q], bv0[q], r0, 0, 0, 0); r1 = __builtin_amdgcn_mfma_f32_16x16x4f32(av[q], bv1[q], r1, 0, 0, 0); }
#pragma unroll
                for (int j = 0; j < 4; ++j) { X[(16 * b + 4 * quad + j) * XS + 32 * w + r16] = r0[j]; X[(16 * b + 4 * quad + j) * XS + 32 * w + 16 + r16] = r1[j]; }
                CHK_BAR();
            }
            if (C.tid < 256) {
                float ab[4], x[16];
#pragma unroll
                for (int k = 0; k < 4; ++k) ab[k] = At[(16 * b + 4 * k + quad) * 64 + 16 * b + r16];
#pragma unroll
                for (int r = 0; r < 16; ++r) x[r] = X[(16 * b + r) * XS + C.tid];
                asm volatile("s_waitcnt lgkmcnt(0)" ::: "memory");
#pragma unroll
                for (int c = 0; c < 15; ++c)
#pragma unroll
                    for (int r = c + 1; r < 16; ++r) {
                        const float a = __uint_as_float(__builtin_amdgcn_readlane(__float_as_uint(ab[c >> 2]), ((c & 3) << 4) | r));
                        x[r] -= a * x[c];
                    }
#pragma unroll
                for (int r = 1; r < 16; ++r) X[(16 * b + r) * XS + C.tid] = x[r];
            }
            CHK_BAR();
        }
        {
            float* Ug = (float*)(PWS + WS_U) + (((size_t)dir * 128 + cg) * 8 + h) * 8192;
            bf16* Wg = (bf16*)(PWS + WS_WK) + (((size_t)dir * 128 + cg) * 8 + h) * 8192;
#pragma unroll
            for (int q = 0; q < 4; ++q) { const int e = C.tid + q * NTHR, i0_ = 16 * ((e >> 6) & 3) + 4 * ((e >> 4) & 3), c_ = 16 * (e >> 8) + (e & 15);
                f32x4 v; v[0] = X[i0_ * XS + c_]; v[1] = X[(i0_ + 1) * XS + c_]; v[2] = X[(i0_ + 2) * XS + c_]; v[3] = X[(i0_ + 3) * XS + c_];
                *(f32x4*)(Ug + (size_t)e * 4) = v; }
#pragma unroll
            for (int q = 0; q < 2; ++q) { const int e = C.tid + q * NTHR, i = e >> 4, c8 = (e & 15) * 8; float f[8];
#pragma unroll
                for (int x = 0; x < 8; ++x) f[x] = X[i * XS + 128 + c8 + x];
                { const int p = e & 15; *(v4u*)(Wg + (size_t)((((i >> 4) * 4 + (p >> 2)) * 64 + (p & 3) * 16 + (i & 15)) * 8)) = pack8(f); } }
        }
    }
    asm volatile("s_waitcnt lgkmcnt(0)" ::: "memory");
#undef CHK_LOAD
}
#undef CHK_BAR
DI int gdn_scan_map(int k, int G) {
    const int b_ = k & 255, x_ = b_ & 7, j_ = b_ >> 3; return G == 256 ? (k & ~255) + (((x_ * 4 + (j_ >> 3)) << 3) | (j_ & 7)) : k;
}
DI void gdn_scan_loop(KP P, const Ctx& C, int nit, int T, int l, int g) {
    const int cps = T >> 6;
    const int lane = C.lane, r16 = lane & 15, quad = lane >> 4, w = C.wave, rt = w & 3;
    LAS bf16* St = (LAS bf16*)(C.L + LDS_SCR);
    LAS bf16* Wt = St + 16 * 136;
    const bf16* QC = (const bf16*)(PWS + WS_QC);
    const bf16* WKb = (const bf16*)(PWS + WS_WK); const float* Ub = (const float*)(PWS + WS_U); const bf16* Pb = (const bf16*)(PWS + WS_P); const bf16* KDT = (const bf16*)(PWS + WS_KDT);
    const float* GAM = (const float*)(PWS + WS_GAM);
    bf16x8 afs0[4], pfs0[2], kdfs0[2], afs1[4], pfs1[2], kdfs1[2], afs2[4], pfs2[2], kdfs2[2], afs3[4], pfs3[2], kdfs3[2];
    f32x4g x4s0, x4s1, x4s2, x4s3; float egls0, egls1, egls2, egls3;
#define GDN_LOAD(S, dX, hX, slX, cgx) do { const int cg_ = (cgx); \
        const size_t ib_ = ((size_t)(dX) * 128 + cg_) * 8 + (hX); \
        const bf16* ap = (w < 4 ? WKb : QC) + ib_ * 8192 + (size_t)(rt * 256 + lane) * 8; \
        _Pragma("unroll") for (int kk = 0; kk < 4; ++kk) af##S[kk] = *(const bf16x8*)(ap + 512 * kk); \
        const bf16* pp = Pb + ib_ * 4096 + (w < 4 ? (size_t)0 : (size_t)(rt * 128 + lane) * 8);     \
        pf##S[0] = *(const bf16x8*)pp; pf##S[1] = *(const bf16x8*)(pp + 512); \
        const float* xp = w < 4 ? Ub + ib_ * 8192 + (size_t)(((slX) * 4 + rt) * 64 + lane) * 4 : GAM + ib_ * 64 + 16 * rt + 4 * quad; \
        x4##S = *(const f32x4g*)xp; \
        { const bf16* kp = KDT + ib_ * 8192 + (size_t)(w * 128 + lane) * 8; kdf##S[0] = *(const bf16x8*)kp; kdf##S[1] = *(const bf16x8*)(kp + 512); \
          egl##S = GAM[ib_ * 64 + 63]; } } while (0)
#define GDN_BAR() asm volatile("s_waitcnt lgkmcnt(0)\n\ts_barrier" ::: "memory")
#define GDN_BODY(CUR, NXT, clx) do { const int cl_ = (clx), cgb = seq * cps + cl_, cq_ = cl_ + 3; const bool same_ = cq_ < cps; \
        if (same_ || has_next) GDN_LOAD(NXT, same_ ? dir : dir2, same_ ? h : h2, same_ ? sl : sl2, same_ ? seq * cps + cq_ : seq2 * cps + cq_ - cps); \
        GDN_BAR();                                                  \
        bf16x8 sb[4]; \
        _Pragma("unroll") for (int kk = 0; kk < 4; ++kk) sb[kk] = *(const LAS bf16x8*)(St + r16 * 136 + 32 * kk + 8 * quad); \
        f32x4g acc = (f32x4g){0.f, 0.f, 0.f, 0.f}; \
        _Pragma("unroll") for (int kk = 0; kk < 4; ++kk) acc = __builtin_amdgcn_mfma_f32_16x16x32_bf16(af##CUR[kk], sb[kk], acc, 0, 0, 0); \
        if (w < 4) { const f32x4g wv = x4##CUR - acc; v2u o; o.x = pk2(wv[0], wv[1]); o.y = pk2(wv[2], wv[3]); *(LAS v2u*)(Wt + r16 * 72 + 16 * rt + 4 * quad) = o; } \
        else { _Pragma("unroll") for (int j = 0; j < 4; ++j) acc[j] *= __expf(x4##CUR[j]); } \
        GDN_BAR();                                                  \
        bf16x8 wb[2]; \
        wb[0] = *(const LAS bf16x8*)(Wt + r16 * 72 + 8 * quad); wb[1] = *(const LAS bf16x8*)(Wt + r16 * 72 + 32 + 8 * quad); \
        if (w >= 4) { \
            acc = __builtin_amdgcn_mfma_f32_16x16x32_bf16(pf##CUR[0], wb[0], acc, 0, 0, 0); \
            acc = __builtin_amdgcn_mfma_f32_16x16x32_bf16(pf##CUR[1], wb[1], acc, 0, 0, 0); \
            _Pragma("unroll") for (int j = 0; j < 4; ++j) { const size_t tok = (size_t)gdn_tok(cgb, 16 * rt + 4 * quad + j, dir, T); OG[tok * 1024 + h * 128 + v0 + r16] = (bf16)pk2(acc[j], 0.f); } \
        } \
        sreg = sreg * __expf(egl##CUR); \
        sreg = __builtin_amdgcn_mfma_f32_16x16x32_bf16(kdf##CUR[0], wb[0], sreg, 0, 0, 0); \
        sreg = __builtin_amdgcn_mfma_f32_16x16x32_bf16(kdf##CUR[1], wb[1], sreg, 0, 0, 0); \
        { v2u o; o.x = pk2(sreg[0], sreg[1]); o.y = pk2(sreg[2], sreg[3]); *(LAS v2u*)(St + r16 * 136 + 16 * w + 4 * quad) = o; } } while (0)
    int k = C.bid;
    if (k < nit) {
        int sl, dir, h, seq;
        { const int it0 = gdn_scan_map(k, C.G); sl = it0 & 7; dir = (it0 >> 3) & 1; h = (it0 >> 4) & 7; seq = it0 >> 7; }
        GDN_LOAD(s0, dir, h, sl, seq * cps); GDN_LOAD(s1, dir, h, sl, seq * cps + 1); GDN_LOAD(s2, dir, h, sl, seq * cps + 2);
        for (; k < nit; k += C.G) {
            const bool has_next = k + C.G < nit;
            const int itn = gdn_scan_map(has_next ? k + C.G : k, C.G);
            const int sl2 = itn & 7, dir2 = (itn >> 3) & 1, h2 = (itn >> 4) & 7, seq2 = itn >> 7;
            const int v0 = 16 * sl;
            bf16* OG = (bf16*)(PWS + (dir ? WS_OGB : WS_OGF));
            f32x4g sreg;
            {
                const int b = g > 0 ? 2 * (g - 1) + seq : 0;
                const float* S0 = PIN(4) + ((((size_t)b * 2 + l) * 2 + dir) * 8 + h) * 16384;
#pragma unroll
                for (int j = 0; j < 4; ++j) sreg[j] = g > 0 ? S0[(size_t)(16 * w + 4 * quad + j) * 128 + v0 + r16] : 0.f;
            }
            GDN_BAR();
            { v2u o; o.x = pk2(sreg[0], sreg[1]); o.y = pk2(sreg[2], sreg[3]); *(LAS v2u*)(St + r16 * 136 + 16 * w + 4 * quad) = o; }
            for (int c = 0; c < cps; c += 4) {
                GDN_BODY(s0, s3, c);
                GDN_BODY(s1, s0, c + 1);
                GDN_BODY(s2, s1, c + 2);
                GDN_BODY(s3, s2, c + 3);
            }
            if (g == 0) {
                float* So = POUT + O_GST + ((((size_t)seq * 2 + l) * 2 + dir) * 8 + h) * 16384;
#pragma unroll
                for (int j = 0; j < 4; ++j) So[(size_t)(16 * w + 4 * quad + j) * 128 + v0 + r16] = sreg[j];
            }
            sl = sl2; dir = dir2; h = h2; seq = seq2;
        }
    }
    asm volatile("s_waitcnt lgkmcnt(0)" ::: "memory");
#undef GDN_BODY
#undef GDN_BAR
#undef GDN_LOAD
}
#ifndef ATT_PLAIN_SDEPTH
#define ATT_PLAIN_SDEPTH 1
#endif
template <int WHICH  > DI void step_mixa(KP P, const Ctx& C, int l, int g) {
    char* lds = (char*)C.lg + LDS_SCR;
    LAS float* biasl = (LAS float*)(C.L + LDS_SCR + at2::SHM_ATTN);
    const bf16* SEG = (const bf16*)(PWS + WS_SEG);
    const bf16 *NAQ = SEG, *NAK = SEG + SEGSZ, *NAV = SEG + 2 * SEGSZ, *DV = SEG + 9 * SEGSZ;
    const bf16 *DQ = g == 0 ? SEG + 7 * SEGSZ : (const bf16*)(PWS + WS_DQR), *DK = g == 0 ? SEG + 8 * SEGSZ : (const bf16*)(PWS + WS_DKR);
    bf16* DOb = (bf16*)(PWS + WS_DO); bf16* ONA = (bf16*)(PWS + WS_ONA);
    const bf16 *CKNA = (const bf16*)(PWS + WS_CKNA), *CVNA = (const bf16*)(PWS + WS_CVNA), *CKD = (const bf16*)(PWS + WS_CKD), *CVD = (const bf16*)(PWS + WS_CVD);
    if constexpr (WHICH < 2) {
    const int u_lo = WHICH == 0 ? 0 : 512, u_hi = WHICH == 0 ? (g == 0 ? 768 : 512) : (g == 0 ? 512 : 768);
    for (int u = u_lo + C.bid; u < u_hi; u += C.G) {
        __syncthreads();
        at2::NaMask mk; mk.on = 0; mk.r0 = 0; mk.kr_lo = 0; mk.bias = biasl;
        const bf16 *Q, *K1, *V1, *K2, *V2; bf16* O; int n1, n2, ldo;
        if (g == 0) {
            if (u < 512) {
                const int ph = u & 15, b = u >> 4, hm = ph >> 1, h = ph >> 2, half = ph & 1;
                Q = DQ + (size_t)(b * 256) * 1024 + hm * 128; K1 = DK + (size_t)(b * 256) * 1024 + hm * 128; V1 = DV + (size_t)(b * 256) * 1024 + h * 256 + half * 128;
                n1 = 256; n2 = 0; K2 = K1; V2 = V1; O = DOb + (size_t)(b * 256) * 2048 + ph * 128; ldo = 2048;
            } else {
                const int u2 = u - 512, h = u2 & 7, b = u2 >> 3;
                Q = NAQ + (size_t)(b * 256) * 1024 + h * 128; K1 = NAK + (size_t)(b * 256) * 1024 + h * 128; V1 = NAV + (size_t)(b * 256) * 1024 + h * 128;
                n1 = 256; n2 = 0; K2 = K1; V2 = V1; O = ONA + (size_t)(b * 256) * 1024 + h * 128; ldo = 1024;
            }
        } else {
            if (u < 512) {
                int qb = u & 15, ph = (u >> 4) & 15, bl = u >> 8;
                if (C.G == 256) { const int x_ = C.bid & 7, j_ = C.bid >> 3; bl = u >> 8; ph = 2 * x_ + (j_ >> 4); qb = j_ & 15; }
                const int b = 2 * (g - 1) + bl, hm = ph >> 1, h = ph >> 2, half = ph & 1;
                Q = DQ + (size_t)(bl * 4096 + qb * 256) * 1024 + hm * 128;
                K1 = DK + (size_t)(bl * 4096) * 1024 + hm * 128; V1 = DV + (size_t)(bl * 4096) * 1024 + h * 256 + half * 128; n1 = 4096;
                K2 = CKD + (size_t)((b * 2 + l) * 256) * 1024 + hm * 128; V2 = CVD + (size_t)((b * 2 + l) * 256) * 1024 + h * 256 + half * 128; n2 = 256;
                O = DOb + (size_t)(bl * 4096 + qb * 256) * 2048 + ph * 128; ldo = 2048;
            } else {
                const int u2 = u - 512; int qb = u2 & 15, h = (u2 >> 4) & 7, bl = u2 >> 7;
                if (C.G == 256) { const int x_ = C.bid & 7, j_ = C.bid >> 3; h = x_; bl = j_ >> 4; qb = j_ & 15; }
                const int b = 2 * (g - 1) + bl;
                const int r0 = 4 * qb;
                int kr_lo = min(max(r0 - 4, 0), 56), kr_hi = min(max(r0 - 1, 0), 56) + 8;
                if ((kr_hi - kr_lo) & 1) { if (kr_hi < 64) ++kr_hi; else --kr_lo; }
                Q = NAQ + (size_t)(bl * 4096 + qb * 256) * 1024 + h * 128;
                K1 = CKNA + (size_t)((b * 2 + l) * 256) * 1024 + h * 128; V1 = CVNA + (size_t)((b * 2 + l) * 256) * 1024 + h * 128; n1 = 256;
                K2 = NAK + (size_t)(bl * 4096 + kr_lo * 64) * 1024 + h * 128; V2 = NAV + (size_t)(bl * 4096 + kr_lo * 64) * 1024 + h * 128; n2 = 64 * (kr_hi - kr_lo);
                O = ONA + (size_t)(bl * 4096 + qb * 256) * 1024 + h * 128; ldo = 1024;
                mk.on = 1; mk.r0 = r0; mk.kr_lo = kr_lo;
                { int e = threadIdx.x; asm volatile("" : "+v"(e)); if (e < 465) biasl[e] = PIN(18)[(size_t)(l * 8 + h) * 465 + e]; }
            }
        }
        at2::attn_body<WHICH == 1, (WHICH == 1 ? 1 : ATT_PLAIN_SDEPTH)>(Q, K1, V1, n1, K2, V2, n2, O, ldo, lds, mk);
    }
    } else {
    const int T = g == 0 ? CT : LT;
    __syncthreads();
    gdn_chunk_loop(P, C, C.bid, 2048, C.G, T);
    __syncthreads();
    }
}


struct BranchOrder {
    pg8::StaticOrder S0;
    DI bool next(int i, pg8::Unit& u) const { const int r = i / 3, b = i - 3 * r; pg8::Unit t; if (!S0.next(r, t)) return false; u.pm = 32 * b + t.pm; u.pn = 8 * b + t.pn; return true; }
    DI void a_ready(const pg8::Unit&) const {}
    DI void done(const pg8::Unit&) const {}
};
__global__ void __launch_bounds__(NTHR, 2) mk_fwd(Params P0) {
    KP P = (KP)__builtin_amdgcn_kernarg_segment_ptr();
    extern __shared__ __attribute__((aligned(16))) unsigned char lds_raw[];
    volatile LAS unsigned* MISC = (volatile LAS unsigned*)((LAS unsigned char*)lds_raw + LDS_MISC);
    for (int u = threadIdx.x; u < 256; u += NTHR) MISC[u] = 0u;
    __syncthreads();
    unsigned* barw = (unsigned*)(PWS + WS_CTL) + 4096;
#ifndef DUP_GEMM
#define DUP_GEMM 1
#endif
#ifndef DUP_ATTN
#define DUP_ATTN 1
#endif
#ifndef DUP_GDN
#define DUP_GDN 1
#endif
#define LI(x) ({ int v_ = (x); asm volatile("" : "+s"(v_)); v_; })
#define STEP_CTX KP P; Ctx C; { KP kp_ = (KP)__builtin_amdgcn_kernarg_segment_ptr(); asm volatile("" : "+s"(kp_)); P = kp_; \
    int t_ = threadIdx.x, b_ = blockIdx.x; asm volatile("" : "+v"(t_)); asm volatile("" : "+s"(b_)); \
    C.tid = t_; C.lane = t_ & 63; C.wave = __builtin_amdgcn_readfirstlane(t_ >> 6); C.G = gridDim.x; C.bid = b_; C.gw = C.bid * NWAVES + C.wave; C.ngw = C.G * NWAVES; \
    LAS unsigned char* lp_ = (LAS unsigned char*)lds_raw; asm volatile("" : "+s"(lp_)); C.L = lp_; C.lg = (unsigned char*)lp_; } \
    PG8_LAS unsigned char* ring = (PG8_LAS unsigned char*)(C.L + LDS_SCR); const bf16* WT = (const bf16*)(PWS + WS_WT); \
    bf16* H = (bf16*)(PWS + WS_H); bf16* Y = (bf16*)(PWS + WS_Y); bf16* ACT = (bf16*)(PWS + WS_ACT); (void)ring; (void)WT; (void)H; (void)Y; (void)ACT;
#if MK_ONE_LAUNCH
    XcdBarrier bar = xcd_barrier_post(barw, MISC + 8);
#define GRID_BAR() do { XcdBarrier b2_ = bar; asm volatile("" : "+s"(b2_.bar)); xcd_barrier(b2_); } while (0)
#define GRID_BAR_F() ([&]() { GRID_BAR(); return 0; }())
#else
#define GRID_BAR() do { } while (0)
#define GRID_BAR_F() 0
#endif
    const int s_lo = P->s_lo, s_hi = P->s_hi;
    int step = 0;
#define RUN (step >= s_lo && step < s_hi)
#define REPFOR(k) for (int r_ = 0, n_ = RUN ? P->rep[k] : 0; r_ < n_; ++r_) if (r_ > 0 && (GRID_BAR_F(), false)) {} else
#define NEXT do { if (RUN && step + 1 < s_hi) { GRID_BAR(); } ++step; } while (0)

    for (int l = 0; l < 2; ++l) {
        REPFOR(0) { STEP_CTX step_weights(P, C, l); if (l == 0) { step_modpartial(P, C); step_caches(P, C); } __syncthreads(); }
        NEXT;
        if (l == 0) {
            if (RUN) { STEP_CTX step_modreduce(P, C); }
            NEXT;
            REPFOR(1) { STEP_CTX step_rows<1, 0>(P, C, 0, -1, 0.f, 0, 0); }
            NEXT;
        }
        for (int f = 0; f < 2; ++f) {
            REPFOR(2) { STEP_CTX
                pg8::Gemm gm{H, WT + (f ? WT_GU2 : WT_GU1), MTOT, 2 * DFF, DM}; pg8::StaticOrder S; S.init(MTOT, 2 * DFF, C.G, C.bid);
                EpiSwiGLU E{ACT};
                pg8::gemm_phase<EpiSwiGLU, pg8::StaticOrder, true, true>(ring, gm, S, E);
            }
            NEXT;
            REPFOR(3) { STEP_CTX
                pg8::Gemm gm{ACT, WT + (f ? WT_DN2 : WT_DN1), MTOT, DM, DFF}; pg8::StaticOrder S; S.init(MTOT, DM, C.G, C.bid);
                EpiBf16Out E{Y, DM};
                pg8::gemm_phase<EpiBf16Out, pg8::StaticOrder, true, true>(ring, gm, S, E);
            }
            NEXT;
            if (f == 0) {
                if (RUN) { STEP_CTX if (l == 0) step_rows<1, 0>(P, C, l, 0, 0.5f, l, 1); else step_rows<0, 0>(P, C, l, 0, 0.5f, l, 1); }
                NEXT;
                for (int g = 0; g <= NGRP; ++g) {
                    if (g >= 1) {
                    REPFOR(10) { STEP_CTX
                        pg8::Gemm gm{(const bf16*)(PWS + WS_MRGB), WT + WT_OUT, MG, DM, DM}; pg8::StaticOrder S; S.init(MG, DM, C.G, C.bid);
                        EpiBf16Out E{Y + (size_t)(g - 1) * MG * DM, DM};
                        pg8::gemm_phase<EpiBf16Out, pg8::StaticOrder, true, true>(ring, gm, S, E);
                    }
                    }
                    if (g < NGRP) {
                    REPFOR(4) { STEP_CTX
                        pg8::Gemm gm{H + (size_t)g * MG * DM, WT + WT_IN, MG, 16384, DM}; pg8::StaticOrder S; S.init(MG, 16384, C.G, C.bid);
                        EpiWin E{(bf16*)(PWS + WS_SEG), (bf16*)(PWS + WS_GATES), POUT, g == 0 ? 1 : 0, l};
                        pg8::gemm_phase<EpiWin, pg8::StaticOrder, true, true>(ring, gm, S, E);
                    }
                    }
                    NEXT;
                    if (g == NGRP) break;
                    REPFOR(11) { STEP_CTX step_prep(P, C, LI(l), LI(g)); }
                    NEXT;
                    REPFOR(5) { { STEP_CTX step_mixa<0>(P, C, LI(l), LI(g)); } if (g > 0) { STEP_CTX step_mixa<1>(P, C, LI(l), LI(g)); } }
                    REPFOR(6) { STEP_CTX step_mixa<2>(P, C, LI(l), LI(g)); }
                    NEXT;
                    REPFOR(7) { STEP_CTX const int T = g == 0 ? CT : LT, nit = (MG / T) * 128; __syncthreads(); gdn_scan_loop(P, C, nit, T, LI(l), LI(g)); }
                    NEXT;
                    REPFOR(8) { STEP_CTX step_post(P, C, LI(l)); }
                    NEXT;
                    REPFOR(9) { STEP_CTX
                        {
                        pg8::Gemm gm{(const bf16*)(PWS + WS_ONA), WT + WT_BR, 3 * MG, 3 * DM, 1024}; BranchOrder S; S.S0.init(MG, DM, C.G, C.bid);
                        EpiBranch E{(const bf16*)(PWS + WS_GATES), (bf16*)(PWS + WS_MRG), (bf16*)(PWS + WS_MRGB)};
                        pg8::gemm_phase<EpiBranch, BranchOrder, true, true>(ring, gm, S, E);
                        }
                    }
                    NEXT;
                }
                if (RUN) { STEP_CTX step_rows<0, 0>(P, C, l, 1, 1.0f, l, 2); }
                NEXT;
            } else {
                if (RUN) { STEP_CTX if (l == 0) step_rows<0, 0>(P, C, l, 2, 0.5f, l + 1, 0); else step_rows<0, 1>(P, C, l, 2, 0.5f, l + 1, -1); }
                NEXT;
            }
        }
    }
    for (int i_ = 0, n_ = (P->rep[12] - 1) * 100; i_ < n_; ++i_) { GRID_BAR(); }
#undef RUN
#undef NEXT
}
constexpr int NSTEPS = 80;

extern "C" void kernel_launch(void* const* d_in, const int* in_sizes, int n_in, void* d_out, int out_size, void* d_ws, size_t ws_size, hipStream_t stream) {
    static int grid = 0;
    if (grid == 0) {
        if (n_in != 29 || (size_t)out_size != O_END || ws_size < WS_END) {
            fprintf(stderr, "kernel_launch: built for 29 inputs, %zu outputs, >= %zu bytes of workspace; got n_in %d out %d ws %zu; nothing launched\n", (size_t)O_END, (size_t)WS_END, n_in, out_size, ws_size);
            grid = -1; return; }
        int dev = 0, cus = 0, per_cu = 0;
        if (hipGetDevice(&dev) != hipSuccess || hipDeviceGetAttribute(&cus, hipDeviceAttributeMultiprocessorCount, dev) != hipSuccess) { grid = -1; return; }
        if (hipFuncSetAttribute((const void*)mk_fwd, hipFuncAttributeMaxDynamicSharedMemorySize, LDS_BYTES) != hipSuccess) { fprintf(stderr, "kernel_launch: hipFuncSetAttribute failed\n"); grid = -1; return; }
        if (hipOccupancyMaxActiveBlocksPerMultiprocessor(&per_cu, (const void*)mk_fwd, NTHR, LDS_BYTES) != hipSuccess || per_cu < 1)
            fprintf(stderr, "kernel_launch: note: occupancy query reports %d workgroups per CU\n", per_cu);
        (void)hipGetLastError();
        grid = cus;
    }
    if (grid < 0) return;
    if (hipMemsetAsync((char*)d_ws + WS_CTL, 0, CTL_ZERO_BYTES, stream) != hipSuccess) { fprintf(stderr, "kernel_launch: memset failed\n"); return; }
    Params p{};
    for (int i = 0; i < 16; ++i) p.rep[i] = 1;
#ifdef PROBE_REP
    p.rep[PROBE_REP] = 2;
#endif
    for (int i = 0; i < 29; ++i) p.in[i] = (const float*)d_in[i];
    p.out = (float*)d_out; p.ws = (unsigned char*)d_ws;
#if MK_ONE_LAUNCH
    p.s_lo = 0; p.s_hi = NSTEPS;
    hipLaunchKernelGGL(mk_fwd, dim3(grid), dim3(NTHR), LDS_BYTES, stream, p);
#else
    for (int s = 0; s < NSTEPS; ++s) { p.s_lo = s; p.s_hi = s + 1; hipLaunchKernelGGL(mk_fwd, dim3(grid), dim3(NTHR), LDS_BYTES, stream, p); }
#endif
    const hipError_t le = hipPeekAtLastError();
    if (le != hipSuccess) fprintf(stderr, "kernel_launch: launch failed: %s\n", hipGetErrorName(le));
}
```
